# Optimizing an MI355X kernel written in HIP

```python
import math
import jax, jax.numpy as jnp
from jax import lax
import numpy as np

D_MODEL = 2048
BATCH = 4
SEQ = 8192
DEPTH = 4
DEC_BATCH = 1
DEC_SEQ = 16384
PAST_LEN = 128

N_MIXERS = 2
N_HYENA = (DEPTH + 1) // 2
N_ATTN = DEPTH // 2
HY_ORDER = 2
HY_SHORT = 3
HY_EMB = 33
HY_BANDS = (HY_EMB - 1) // 2
HY_FILTER_W = 64
HY_FAST_PCT = 0.3
HY_SLOW_PCT = 1.5
HY_TARGET = 1e-2
N_HEADS = 16
HEAD_DIM = 128
N_KV = 4
GQA_G = N_HEADS // N_KV
WINDOW = 128
BLOCK = 128
N_BUCKETS = 32
MAX_DIST = 128
D_FF = -(-(8 * D_MODEL) // (3 * 256)) * 256
EPS = 1e-6
NEG = -1e30

kernel_name = "hyena_swa_gqa_hybrid_encoder"


def rmsnorm(x, g):
    xf = x.astype(jnp.float32)
    y = xf * lax.rsqrt(jnp.mean(xf * xf, axis=-1, keepdims=True) + EPS)
    return (y * g.astype(jnp.float32)).astype(x.dtype)


def swiglu(h, w_gate_up, w_down):
    gu = h @ w_gate_up
    g, u = gu[..., :D_FF], gu[..., D_FF:]
    return (jax.nn.silu(g) * u) @ w_down


def hyena_filters(L, f_w1, f_b1, f_w2, f_b2, f_w3, f_b3, f_wout, f_freq):
    t = jnp.linspace(0.0, 1.0, L, dtype=jnp.float32)[:, None]
    w = 2.0 * math.pi * jnp.arange(L, dtype=jnp.float32) / L
    f = jnp.linspace(1e-4, HY_BANDS - 1, HY_BANDS, dtype=jnp.float32)
    ang = w[:, None] * f[None, :]
    feats = jnp.concatenate([t, jnp.cos(ang), -jnp.sin(ang)], axis=-1)
    fr = f_freq.astype(jnp.float32)
    a = jnp.sin(fr * (feats @ f_w1 + f_b1))
    a = jnp.sin(fr * (a @ f_w2 + f_b2))
    a = jnp.sin(fr * (a @ f_w3 + f_b3))
    h = (a @ f_wout).astype(jnp.float32).reshape(L, HY_ORDER, 2, D_MODEL)
    deltas = np.abs(np.linspace(math.log(HY_TARGET) / HY_SLOW_PCT,
                                math.log(HY_TARGET) / HY_FAST_PCT, D_MODEL)).astype(np.float32)
    decay = jnp.exp(-t * deltas[None, :])
    h = h * decay[:, None, None, :]
    hf = h[:, :, 0]
    hb = h[:, :, 1]
    k = jnp.concatenate([hf, jnp.zeros((1, HY_ORDER, D_MODEL), jnp.float32), hb[:0:-1]], axis=0)
    k = k / jnp.sum(jnp.abs(k), axis=0, keepdims=True)
    return jnp.fft.rfft(k, n=2 * L, axis=0)


def long_conv(z, kf):
    L = z.shape[1]
    Z = jnp.fft.rfft(z.astype(jnp.float32), n=2 * L, axis=1)
    y = jnp.fft.irfft(Z * kf[None], n=2 * L, axis=1)[:, :L]
    return y.astype(z.dtype)


def hyena_mixer(h, w_in, b_in, conv_w, conv_b, f_w1, f_b1, f_w2, f_b2, f_w3, f_b3,
                f_wout, f_freq, skip, w_out, b_out):
    B, L, _ = h.shape
    u = h @ w_in + b_in
    up = jnp.pad(u, ((0, 0), (1, 1), (0, 0)))
    uc = conv_w[0] * up[:, :-2] + conv_w[1] * up[:, 1:-1] + conv_w[2] * up[:, 2:] + conv_b
    v, x1, x2 = uc[..., :D_MODEL], uc[..., D_MODEL:2 * D_MODEL], uc[..., 2 * D_MODEL:]
    kf = hyena_filters(L, f_w1, f_b1, f_w2, f_b2, f_w3, f_b3, f_wout, f_freq)
    z = v
    for o, gate in enumerate((x1, x2)):
        z = gate * (long_conv(z, kf[:, o]) + skip[o] * z)
    return z @ w_out + b_out


def _band_structure():
    qi = np.arange(BLOCK)[:, None]
    ki = np.arange(3 * BLOCK)[None, :]
    rel = ki - BLOCK - qi
    nb = N_BUCKETS // 2
    max_exact = nb // 2
    n = np.abs(rel)
    large = max_exact + (np.log(np.maximum(n, 1) / max_exact) / math.log(MAX_DIST / max_exact)
                         * (nb - max_exact)).astype(np.int32)
    large = np.minimum(large, nb - 1)
    buckets = (rel > 0).astype(np.int32) * nb + np.where(n < max_exact, n, large).astype(np.int32)
    band = n <= WINDOW
    return buckets, band


def window_attention(h, w_qkv, q_g, k_g, sink, w_o, rel_bias):
    B, L, _ = h.shape
    nb = L // BLOCK
    qkv = h @ w_qkv
    nq, nk = N_HEADS * HEAD_DIM, N_KV * HEAD_DIM
    q = rmsnorm(qkv[..., :nq].reshape(B, L, N_HEADS, HEAD_DIM), q_g)
    k = rmsnorm(qkv[..., nq:nq + nk].reshape(B, L, N_KV, HEAD_DIM), k_g)
    v = qkv[..., nq + nk:].reshape(B, L, N_KV, HEAD_DIM)
    qb = q.reshape(B, nb, BLOCK, N_KV, GQA_G, HEAD_DIM)

    def windows(t):
        tp = jnp.pad(t, ((0, 0), (BLOCK, BLOCK), (0, 0), (0, 0))).reshape(B, nb + 2, BLOCK, N_KV, HEAD_DIM)
        return jnp.concatenate([tp[:, :-2], tp[:, 1:-1], tp[:, 2:]], axis=2)

    kw, vw = windows(k), windows(v)
    s = jnp.einsum("bnqhgd,bnkhd->bnhgqk", qb, kw).astype(jnp.float32) * (HEAD_DIM ** -0.5)
    buckets, band = _band_structure()
    bias = rel_bias[buckets].astype(jnp.float32)
    bias = jnp.transpose(bias, (2, 0, 1)).reshape(N_KV, GQA_G, BLOCK, 3 * BLOCK)
    kpos = np.arange(nb)[:, None] * BLOCK + np.arange(3 * BLOCK)[None, :] - BLOCK
    valid = band[None] & ((kpos >= 0) & (kpos < L))[:, None, :]
    s = jnp.where(valid[None, :, None, None], s + bias, NEG)
    sk = sink.astype(jnp.float32).reshape(1, 1, N_KV, GQA_G, 1, 1)
    m = jnp.maximum(jnp.max(s, axis=-1, keepdims=True), sk)
    p = jnp.exp(s - m)
    p = p / (jnp.sum(p, axis=-1, keepdims=True) + jnp.exp(sk - m))
    o = jnp.einsum("bnhgqk,bnkhd->bnqhgd", p.astype(vw.dtype), vw).reshape(B, L, nq)
    return o @ w_o


def trunk(x, norm_mix_g, norm_ffn_g, hy_w_in, hy_b_in, hy_conv_w, hy_conv_b,
          hy_f_w1, hy_f_b1, hy_f_w2, hy_f_b2, hy_f_w3, hy_f_b3, hy_f_wout, hy_f_freq,
          hy_skip, hy_w_out, hy_b_out, at_w_qkv, at_q_g, at_k_g, at_sink, at_w_o,
          rel_bias, ffn_w_gate_up, ffn_w_down):
    for i in range(DEPTH):
        j = i // N_MIXERS
        h = rmsnorm(x, norm_mix_g[i])
        if i % N_MIXERS == 0:
            y = hyena_mixer(h, hy_w_in[j], hy_b_in[j], hy_conv_w[j], hy_conv_b[j],
                            hy_f_w1[j], hy_f_b1[j], hy_f_w2[j], hy_f_b2[j], hy_f_w3[j], hy_f_b3[j],
                            hy_f_wout[j], hy_f_freq[j], hy_skip[j], hy_w_out[j], hy_b_out[j])
        else:
            y = window_attention(h, at_w_qkv[j], at_q_g[j], at_k_g[j], at_sink[j], at_w_o[j], rel_bias)
        x = x + y
        x = x + swiglu(rmsnorm(x, norm_ffn_g[i]), ffn_w_gate_up[i], ffn_w_down[i])
    return x


def setup_inputs(seed: int = 0) -> dict:
    key = jax.random.key(seed)
    ks = jax.random.split(key, 32)

    def nrm(k, shape, scale):
        return jax.random.normal(k, shape, jnp.float32) * scale

    D = D_MODEL
    qkv_w = (N_HEADS + 2 * N_KV) * HEAD_DIM
    return {
        "x_prompt": nrm(ks[0], (BATCH, SEQ, D), 1.0),
        "x_sample": nrm(ks[1], (DEC_BATCH, DEC_SEQ, D), 1.0),
        "norm_mix_g": 1.0 + nrm(ks[2], (DEPTH, D), 0.02),
        "norm_ffn_g": 1.0 + nrm(ks[3], (DEPTH, D), 0.02),
        "hy_w_in": nrm(ks[4], (N_HYENA, D, 3 * D), D ** -0.5),
        "hy_b_in": nrm(ks[5], (N_HYENA, 3 * D), 0.02),
        "hy_conv_w": nrm(ks[6], (N_HYENA, HY_SHORT, 3 * D), HY_SHORT ** -0.5),
        "hy_conv_b": nrm(ks[7], (N_HYENA, 3 * D), 0.02),
        "hy_f_w1": nrm(ks[8], (N_HYENA, HY_EMB, HY_FILTER_W), HY_EMB ** -0.5),
        "hy_f_b1": nrm(ks[9], (N_HYENA, HY_FILTER_W), 0.02),
        "hy_f_w2": nrm(ks[10], (N_HYENA, HY_FILTER_W, HY_FILTER_W), HY_FILTER_W ** -0.5),
        "hy_f_b2": nrm(ks[11], (N_HYENA, HY_FILTER_W), 0.02),
        "hy_f_w3": nrm(ks[12], (N_HYENA, HY_FILTER_W, HY_FILTER_W), HY_FILTER_W ** -0.5),
        "hy_f_b3": nrm(ks[13], (N_HYENA, HY_FILTER_W), 0.02),
        "hy_f_wout": nrm(ks[14], (N_HYENA, HY_FILTER_W, HY_ORDER * 2 * D), HY_FILTER_W ** -0.5),
        "hy_f_freq": 1.0 + nrm(ks[15], (N_HYENA, HY_FILTER_W), 0.1),
        "hy_skip": nrm(ks[16], (N_HYENA, HY_ORDER, D), 1.0),
        "hy_w_out": nrm(ks[17], (N_HYENA, D, D), D ** -0.5),
        "hy_b_out": nrm(ks[18], (N_HYENA, D), 0.02),
        "at_w_qkv": nrm(ks[19], (N_ATTN, D, qkv_w), D ** -0.5),
        "at_q_g": 1.0 + nrm(ks[20], (N_ATTN, HEAD_DIM), 0.02),
        "at_k_g": 1.0 + nrm(ks[21], (N_ATTN, HEAD_DIM), 0.02),
        "at_sink": nrm(ks[22], (N_ATTN, N_HEADS), 1.0),
        "at_w_o": nrm(ks[23], (N_ATTN, N_HEADS * HEAD_DIM, D), (N_HEADS * HEAD_DIM) ** -0.5),
        "rel_bias": nrm(ks[24], (N_BUCKETS, N_HEADS), 0.1),
        "ffn_w_gate_up": nrm(ks[25], (DEPTH, D, 2 * D_FF), D ** -0.5),
        "ffn_w_down": nrm(ks[26], (DEPTH, D_FF, D), D_FF ** -0.5),
    }


def reference(x_prompt, x_sample, norm_mix_g, norm_ffn_g, hy_w_in, hy_b_in, hy_conv_w, hy_conv_b,
              hy_f_w1, hy_f_b1, hy_f_w2, hy_f_b2, hy_f_w3, hy_f_b3, hy_f_wout, hy_f_freq,
              hy_skip, hy_w_out, hy_b_out, at_w_qkv, at_q_g, at_k_g, at_sink, at_w_o,
              rel_bias, ffn_w_gate_up, ffn_w_down):
    y_prompt = trunk(x_prompt, norm_mix_g, norm_ffn_g, hy_w_in, hy_b_in, hy_conv_w, hy_conv_b,
                     hy_f_w1, hy_f_b1, hy_f_w2, hy_f_b2, hy_f_w3, hy_f_b3, hy_f_wout, hy_f_freq,
                     hy_skip, hy_w_out, hy_b_out, at_w_qkv, at_q_g, at_k_g, at_sink, at_w_o,
                     rel_bias, ffn_w_gate_up, ffn_w_down)
    y_sample = trunk(x_sample, norm_mix_g, norm_ffn_g, hy_w_in, hy_b_in, hy_conv_w, hy_conv_b,
                     hy_f_w1, hy_f_b1, hy_f_w2, hy_f_b2, hy_f_w3, hy_f_b3, hy_f_wout, hy_f_freq,
                     hy_skip, hy_w_out, hy_b_out, at_w_qkv, at_q_g, at_k_g, at_sink, at_w_o,
                     rel_bias, ffn_w_gate_up, ffn_w_down)
    return (y_prompt, y_sample)
```

```cpp
#include <hip/hip_runtime.h>
#include <cstdio>
#include <cstdint>
#define FC_ASM_CMUL
#define FC_ASM_CMULK
namespace pg8 {
#define PG8_LAS __attribute__((address_space(3)))
typedef unsigned short bf16_t;
typedef short bf16x8 __attribute__((ext_vector_type(8)));
typedef float f32x4 __attribute__((ext_vector_type(4)));
typedef unsigned u32x4 __attribute__((ext_vector_type(4)));
constexpr int BM = 256, BK = 64, HALF = 128, HTB = HALF * BK * 2  , STAGE_BYTES = 8 * HTB, NXCD = 8, WGM = 4;

__host__ __device__ __forceinline__ int lds_byte(int r, int c) { const int st = (r >> 4) * 2 + (c >> 5), rr = r & 15, cc = c & 31, ob = rr * 64 + cc * 2; return st * 1024 + (ob ^ (((ob >> 9) & 1) << 5)); }
__host__ __device__ __forceinline__ void stage_rc(int b, int& R, int& C) { const int st = b / 1024, sb = b % 1024, swz = sb ^ (((sb >> 9) & 1) << 5); R = (st >> 1) * 16 + swz / 64; C = (st & 1) * 32 + (swz % 64) / 2; }
__host__ __device__ __forceinline__ int perm32(int rho) { const int n = rho >> 4, i = rho & 15; return 8 * (i >> 2) + 4 * n + (i & 3); }

struct Unit { int pm, pn; };
struct Gemm { const bf16_t* A; const bf16_t* Bt; int M, N, K; };

struct StaticOrder {
    int nM, nN, nwg, G, c;
    __host__ __device__ void init(int M, int N, int G_, int c_) { nM = M / BM; nN = N / BM; nwg = nM * nN; G = G_; c = c_; }
    __host__ __device__ bool next(int i, Unit& u) const {
        const long L = (long)i * G + c; if (L >= nwg) return false;
        int wgid = (int)L; { const int q = nwg / NXCD, r = nwg % NXCD, xcd = wgid % NXCD, off = wgid / NXCD; wgid = (xcd < r ? xcd * (q + 1) : r * (q + 1) + (xcd - r) * q) + off; }
        const int nig = WGM * nN, gid = wgid / nig, fm = gid * WGM, gsz = (nM - fm) < WGM ? (nM - fm) : WGM;
        u.pm = fm + ((wgid % nig) % gsz); u.pn = (wgid % nig) / gsz; return true;
    }
    __device__ __forceinline__ void a_ready(const Unit&) const {}
    __device__ __forceinline__ void done(const Unit&) const {}
};

__device__ __forceinline__ unsigned cvt_pk_bf16(float lo, float hi) { unsigned r; asm volatile("v_cvt_pk_bf16_f32 %0, %1, %2" : "=v"(r) : "v"(lo), "v"(hi)); return r; }
typedef float f32x2 __attribute__((ext_vector_type(2)));
__device__ __forceinline__ unsigned cvt_pk_f16(float lo, float hi) { typedef _Float16 h2_t __attribute__((ext_vector_type(2))); h2_t v; v.x = (_Float16)lo; v.y = (_Float16)hi; return __builtin_bit_cast(unsigned, v); }
__device__ __forceinline__ float rstd_of(float ss) { return __builtin_amdgcn_rsqf(ss * (1.0f / 2048.0f) + 1e-6f); }
__device__ __forceinline__ float rstd8(const float* rss, int t) { const f32x4 a = *(const f32x4*)(rss + (size_t)t * 8), b = *(const f32x4*)(rss + (size_t)t * 8 + 4); return rstd_of(((a[0] + a[1]) + (a[2] + a[3])) + ((b[0] + b[1]) + (b[2] + b[3]))); }
__device__ __forceinline__ void rss_prefetch(PG8_LAS float* raw, const float* rss, int tok0, int wid, int lane) {
    __builtin_amdgcn_global_load_lds((const unsigned*)(rss + (size_t)tok0 * 8 + (wid * 64 + lane) * 4), (PG8_LAS unsigned*)(raw + wid * 256), 16, 0, 0);
}
__device__ __forceinline__ void rstd_table(PG8_LAS float* tab, PG8_LAS const float* raw, int wr, int wc, int fr, int fq) {
    if (wr == 0) { const int r = wc * 64 + fr + 16 * fq; const f32x4 a = *(PG8_LAS const f32x4*)(raw + r * 8), b = *(PG8_LAS const f32x4*)(raw + r * 8 + 4);
        tab[r] = rstd_of(((a[0] + a[1]) + (a[2] + a[3])) + ((b[0] + b[1]) + (b[2] + b[3]))); }
    asm volatile("s_waitcnt lgkmcnt(0)" ::: "memory"); __builtin_amdgcn_s_barrier(); asm volatile("" ::: "memory");
}
struct EpiBf16 {
    static constexpr bool PERM = true, AFTER_DRAIN = false;
    bf16_t* O; int ldc; const float* rbias; const float* rss_row; const float* rss_col; PG8_LAS float* tab; PG8_LAS float* raw;
    __device__ __forceinline__ void prefetch(const Unit& u, int wid, int lane) const { if (rss_col) rss_prefetch(raw, rss_col, u.pn * BM, wid, lane); else if (rss_row) rss_prefetch(raw, rss_row, u.pm * BM, wid, lane); }
    __device__ __forceinline__ void operator()(const f32x4 (&acc)[2][2][4][2], const Unit& u, int wr, int wc, int fr, int fq) const {
        const int row0 = u.pm * BM + wr * 64 + fr, col0 = u.pn * BM + wc * 32 + 8 * fq;
        f32x4 cs[2][2];
#pragma unroll
        for (int bj = 0; bj < 2; ++bj)
#pragma unroll
            for (int n = 0; n < 2; ++n) cs[bj][n] = (f32x4){1.f, 1.f, 1.f, 1.f};
        if (rss_col) { rstd_table(tab, raw, wr, wc, fr, fq);
#pragma unroll
            for (int bj = 0; bj < 2; ++bj)
#pragma unroll
                for (int n = 0; n < 2; ++n) cs[bj][n] = *(const PG8_LAS f32x4*)(tab + bj * HALF + wc * 32 + 8 * fq + 4 * n); }
        if (rss_row) rstd_table(tab, raw, wr, wc, fr, fq);
#pragma unroll
        for (int ai = 0; ai < 2; ++ai)
#pragma unroll
            for (int m = 0; m < 4; ++m) { const int row = row0 + ai * HALF + m * 16; bf16_t* rowp = O + (size_t)row * ldc + col0; const float b = rbias ? rbias[row] : 0.f;
                const float rs = rss_row ? tab[ai * HALF + wr * 64 + m * 16 + fr] : 1.f;
#pragma unroll
                for (int bj = 0; bj < 2; ++bj) { const f32x4 v0 = acc[ai][bj][m][0] * cs[bj][0] * rs + b, v1 = acc[ai][bj][m][1] * cs[bj][1] * rs + b;
                    u32x4 w; w.x = cvt_pk_bf16(v0[0], v0[1]); w.y = cvt_pk_bf16(v0[2], v0[3]); w.z = cvt_pk_bf16(v1[0], v1[1]); w.w = cvt_pk_bf16(v1[2], v1[3]);
                    __builtin_nontemporal_store(w, (u32x4*)(rowp + bj * HALF)); } }
    }
};
struct EpiSwiGLU {
    static constexpr bool PERM = true, AFTER_DRAIN = false;
    bf16_t* O; int ldc; const float* rss_row; PG8_LAS float* tab; PG8_LAS float* raw;
    __device__ __forceinline__ void prefetch(const Unit& u, int wid, int lane) const { rss_prefetch(raw, rss_row, u.pm * BM, wid, lane); }
    static __device__ __forceinline__ f32x4 sw4(f32x4 g, f32x4 u, float c1, float rs2) {
        const f32x4 t = g * c1;
        f32x4 e; e[0] = __builtin_amdgcn_exp2f(t[0]); e[1] = __builtin_amdgcn_exp2f(t[1]); e[2] = __builtin_amdgcn_exp2f(t[2]); e[3] = __builtin_amdgcn_exp2f(t[3]);
        const f32x4 d = e + 1.0f;
        f32x4 r; r[0] = __builtin_amdgcn_rcpf(d[0]); r[1] = __builtin_amdgcn_rcpf(d[1]); r[2] = __builtin_amdgcn_rcpf(d[2]); r[3] = __builtin_amdgcn_rcpf(d[3]);
        return ((g * u) * rs2) * r;
    }
    __device__ __forceinline__ void operator()(const f32x4 (&acc)[2][2][4][2], const Unit& u, int wr, int wc, int fr, int fq) const {
        const int row0 = u.pm * BM + wr * 64 + fr, col0 = u.pn * HALF + wc * 32 + 8 * fq;
        rstd_table(tab, raw, wr, wc, fr, fq);
#pragma unroll
        for (int ai = 0; ai < 2; ++ai)
#pragma unroll
            for (int m = 0; m < 4; ++m) { const int row = row0 + ai * HALF + m * 16; bf16_t* rowp = O + (size_t)row * ldc + col0;
                const float rs = tab[ai * HALF + wr * 64 + m * 16 + fr], c1 = -1.4426950408889634f * rs, rs2 = rs * rs;
                const f32x4 h0 = sw4(acc[ai][0][m][0], acc[ai][1][m][0], c1, rs2), h1 = sw4(acc[ai][0][m][1], acc[ai][1][m][1], c1, rs2);
                u32x4 w; w.x = cvt_pk_bf16(h0[0], h0[1]); w.y = cvt_pk_bf16(h0[2], h0[3]); w.z = cvt_pk_bf16(h1[0], h1[1]); w.w = cvt_pk_bf16(h1[2], h1[3]);
                __builtin_nontemporal_store(w, (u32x4*)rowp); }
    }
};
struct EpiRes16 {
    static constexpr bool PERM = true, AFTER_DRAIN = false;
    bf16_t* XN; int ldc; const float* bias; float* OUT; float* rss; PG8_LAS float* part;
    __device__ __forceinline__ void prefetch(const Unit& u, int wid, int lane) const {
        const int l = wid * 64 + lane;
        __builtin_amdgcn_global_load_lds((const unsigned*)(XN + (size_t)(u.pm * BM + (l >> 2)) * ldc + u.pn * BM + (l & 3) * 64), (PG8_LAS unsigned*)((PG8_LAS unsigned char*)part + 5120) + wid * 64, 4, 0, 0);
    }
    __device__ __forceinline__ void operator()(const f32x4 (&acc)[2][2][4][2], const Unit& u, int wr, int wc, int fr, int fq) const {
        const int row0 = u.pm * BM + wr * 64 + fr, col0 = u.pn * BM + wc * 32 + 8 * fq;
        f32x4 bv[2][2];
#pragma unroll
        for (int bj = 0; bj < 2; ++bj)
#pragma unroll
            for (int n = 0; n < 2; ++n) bv[bj][n] = bias ? *(const f32x4*)(bias + col0 + bj * HALF + 4 * n) : (f32x4){0.f, 0.f, 0.f, 0.f};
        u32x4 xin[4][2];
#pragma unroll
        for (int m = 0; m < 4; ++m)
#pragma unroll
            for (int bj = 0; bj < 2; ++bj) xin[m][bj] = *(const u32x4*)(XN + (size_t)(row0 + m * 16) * ldc + col0 + bj * HALF);
#pragma unroll
        for (int ai = 0; ai < 2; ++ai) {
#pragma unroll
            for (int m = 0; m < 4; ++m) { const int row = row0 + ai * HALF + m * 16;
                float ss = 0.f;
                f32x4 xs[2][2];
#pragma unroll
                for (int bj = 0; bj < 2; ++bj) { const u32x4 xi = xin[m][bj];
                    f32x4 x0 = acc[ai][bj][m][0] + bv[bj][0], x1 = acc[ai][bj][m][1] + bv[bj][1];
                    x0[0] += __builtin_bit_cast(float, xi[0] << 16); x0[1] += __builtin_bit_cast(float, xi[0] & 0xffff0000u); x0[2] += __builtin_bit_cast(float, xi[1] << 16); x0[3] += __builtin_bit_cast(float, xi[1] & 0xffff0000u);
                    x1[0] += __builtin_bit_cast(float, xi[2] << 16); x1[1] += __builtin_bit_cast(float, xi[2] & 0xffff0000u); x1[2] += __builtin_bit_cast(float, xi[3] << 16); x1[3] += __builtin_bit_cast(float, xi[3] & 0xffff0000u);
                    xs[bj][0] = x0; xs[bj][1] = x1; }
                if (ai == 0) {
#pragma unroll
                    for (int bj = 0; bj < 2; ++bj) xin[m][bj] = *(const u32x4*)(XN + (size_t)(row0 + HALF + m * 16) * ldc + col0 + bj * HALF); }
#pragma unroll
                for (int bj = 0; bj < 2; ++bj) { const f32x4 x0 = xs[bj][0], x1 = xs[bj][1];
                    if (OUT) { float* op = OUT + (size_t)row * ldc + col0 + bj * HALF; *(f32x4*)op = x0; *(f32x4*)(op + 4) = x1; }
                    else { u32x4 w; w.x = cvt_pk_bf16(x0[0], x0[1]); w.y = cvt_pk_bf16(x0[2], x0[3]); w.z = cvt_pk_bf16(x1[0], x1[1]); w.w = cvt_pk_bf16(x1[2], x1[3]);
                        *(u32x4*)(XN + (size_t)row * ldc + col0 + bj * HALF) = w;
                        const float r0 = __builtin_bit_cast(float, w.x << 16), r1 = __builtin_bit_cast(float, w.x & 0xffff0000u), r2 = __builtin_bit_cast(float, w.y << 16), r3 = __builtin_bit_cast(float, w.y & 0xffff0000u);
                        const float r4 = __builtin_bit_cast(float, w.z << 16), r5 = __builtin_bit_cast(float, w.z & 0xffff0000u), r6 = __builtin_bit_cast(float, w.w << 16), r7 = __builtin_bit_cast(float, w.w & 0xffff0000u);
                        ss += ((r0 * r0 + r1 * r1) + (r2 * r2 + r3 * r3)) + ((r4 * r4 + r5 * r5) + (r6 * r6 + r7 * r7)); } }
                if (rss) {
                    { const unsigned us = __builtin_bit_cast(unsigned, ss); const auto r16 = __builtin_amdgcn_permlane16_swap(us, us, false, false); ss = __builtin_bit_cast(float, (unsigned)r16[0]) + __builtin_bit_cast(float, (unsigned)r16[1]); }
                    { const unsigned us = __builtin_bit_cast(unsigned, ss); const auto r32 = __builtin_amdgcn_permlane32_swap(us, us, false, false); ss = __builtin_bit_cast(float, (unsigned)r32[0]) + __builtin_bit_cast(float, (unsigned)r32[1]); }
                    if (fq == 0) part[(ai * HALF + wr * 64 + m * 16 + fr) * 4 + wc] = ss; } }
            asm volatile("" ::: "memory"); }
        if (rss) {
            asm volatile("s_waitcnt lgkmcnt(0)" ::: "memory"); __builtin_amdgcn_s_barrier(); asm volatile("" ::: "memory");
            if (wr == 0) { const int r = wc * 64 + fr + 16 * fq; const f32x4 p4 = *(const PG8_LAS f32x4*)(part + r * 4); rss[(size_t)(u.pm * BM + r) * 8 + u.pn] = (p4[0] + p4[1]) + (p4[2] + p4[3]); }
        }
    }
};
struct EpiTaps {
    static constexpr bool PERM = true, AFTER_DRAIN = false;
    unsigned short* O; int ldc;
    __device__ __forceinline__ void prefetch(const Unit&, int, int) const {}
    __device__ __forceinline__ void operator()(const f32x4 (&acc)[2][2][4][2], const Unit& u, int wr, int wc, int fr, int fq) const {
        const int row0 = u.pm * BM + wr * 64 + fr, col0 = u.pn * BM + wc * 32 + 8 * fq;
        float tt[2][8];
#pragma unroll
        for (int bj = 0; bj < 2; ++bj)
#pragma unroll
            for (int e = 0; e < 8; ++e) { const int i = col0 + bj * HALF + e; tt[bj][e] = (i < 8192) ? (float)i * (1.0f / 8191.0f) : (float)(i - 8192) * (1.0f / 16383.0f); }
#pragma unroll
        for (int ai = 0; ai < 2; ++ai)
#pragma unroll
            for (int m = 0; m < 4; ++m) { const int row = row0 + ai * HALF + m * 16; unsigned short* rowp = O + (size_t)row * ldc + col0;
                const float delta = 3.0701134573253944f + (float)(row & 2047) * (float)((15.350567286626973 - 3.0701134573253944) / 2047.0);
                const float nd = -1.4426950408889634f * delta;
#pragma unroll
                for (int bj = 0; bj < 2; ++bj) { const f32x4 v0 = acc[ai][bj][m][0], v1 = acc[ai][bj][m][1];
                    float r[8];
#pragma unroll
                    for (int e = 0; e < 4; ++e) { r[e] = v0[e] * __builtin_amdgcn_exp2f(tt[bj][e] * nd); r[4 + e] = v1[e] * __builtin_amdgcn_exp2f(tt[bj][4 + e] * nd); }
                    u32x4 w; w.x = cvt_pk_f16(r[0], r[1]); w.y = cvt_pk_f16(r[2], r[3]); w.z = cvt_pk_f16(r[4], r[5]); w.w = cvt_pk_f16(r[6], r[7]);
                    *(u32x4*)(rowp + bj * HALF) = w; } }
    }
};
template <class Epi, class Sched, bool ALIGN_EPI = false, bool SP2 = false>
__device__ __forceinline__ void gemm_phase(PG8_LAS unsigned char* lds, const Gemm g, const Sched& S, const Epi& E, const int wave_id) {
    int tid_; asm volatile("v_mbcnt_lo_u32_b32 %0, -1, 0\n\tv_mbcnt_hi_u32_b32 %0, -1, %0" : "=v"(tid_)); tid_ += wave_id * 64;
    const int tid = tid_, wid = __builtin_amdgcn_readfirstlane(tid >> 6), lane = tid & 63, wr = wid >> 2, wc = wid & 3, fr = lane & 15, fq = lane >> 4;
    const int K = g.K, nt = K / BK;
    unsigned voffA[2], voffB[2];
#pragma unroll
    for (int i = 0; i < 2; ++i) { int R, C; stage_rc(tid * 16 + i * 8192, R, C); const int Rb = Epi::PERM ? ((R & ~31) + perm32(R & 31)) : R;
        voffA[i] = (unsigned)(R * K + C) * 2u; voffB[i] = (unsigned)(Rb * K + C) * 2u; }
    const size_t kstep = (size_t)(BK * 2);
    const size_t hstep = (size_t)HALF * K * 2;
    const size_t tstep = 2 * hstep;
    const unsigned ldsw = (unsigned)wid * 1024u;
    const int aoff = lds_byte(wr * 64 + fr, fq * 8), boff = lds_byte(wc * 32 + fr, fq * 8);
#define PG8_SA(b, h) (((b) * 2 + (h)) * HTB)
#define PG8_SB(b, h) ((4 + (b) * 2 + (h)) * HTB)
#define PG8_STAGE(bufoff, gbase, voff) do { _Pragma("unroll") for (int _i = 0; _i < 2; ++_i) \
        __builtin_amdgcn_global_load_lds((const unsigned*)((const char*)(gbase) + (voff)[_i]), (PG8_LAS unsigned*)(lds + (bufoff) + ldsw + _i * 8192), 16, 0, 0); } while (0)
#define PG8_LDA(dst, b, h) do { _Pragma("unroll") for (int m = 0; m < 4; ++m) _Pragma("unroll") for (int k = 0; k < 2; ++k) dst[m][k] = *(const PG8_LAS bf16x8*)(lds + PG8_SA(b, h) + aoff + m * 2048 + k * 1024); } while (0)
#define PG8_LDB(dst, b, h) do { _Pragma("unroll") for (int n = 0; n < 2; ++n) _Pragma("unroll") for (int k = 0; k < 2; ++k) dst[n][k] = *(const PG8_LAS bf16x8*)(lds + PG8_SB(b, h) + boff + n * 2048 + k * 1024); } while (0)
#define PG8_MMA(ai, bj, At, Bt) do { __builtin_amdgcn_s_setprio(1); _Pragma("unroll") for (int m = 0; m < 4; ++m) _Pragma("unroll") for (int n = 0; n < 2; ++n) _Pragma("unroll") for (int k = 0; k < 2; ++k) \
        acc[ai][bj][m][n] = __builtin_amdgcn_mfma_f32_16x16x32_bf16(Bt[n][k], At[m][k], acc[ai][bj][m][n], 0, 0, 0); __builtin_amdgcn_s_setprio(0); } while (0)
#define PG8_WAIT_V(n) asm volatile("s_waitcnt vmcnt(" #n ")" ::: "memory")
#define PG8_WAIT_L(n) asm volatile("s_waitcnt lgkmcnt(" #n ")" ::: "memory")
#define PG8_BAR __builtin_amdgcn_s_barrier()
#define PG8_SCHED __builtin_amdgcn_sched_barrier(0)
    Unit cur, nxt; int ui = 0;
    if (!S.next(0, cur)) return;
    E.prefetch(cur, wid, lane);
    f32x4 acc[2][2][4][2];
#pragma unroll
    for (int a = 0; a < 2; ++a)
#pragma unroll
        for (int b = 0; b < 2; ++b)
#pragma unroll
            for (int m = 0; m < 4; ++m)
#pragma unroll
                for (int n = 0; n < 2; ++n) acc[a][b][m][n] = (f32x4){0.f, 0.f, 0.f, 0.f};
    bf16x8 At[4][2], B0[2][2], B1[2][2];
    const char* cA = (const char*)g.A + (size_t)cur.pm * tstep; const char* cB = (const char*)g.Bt + (size_t)cur.pn * tstep;
    S.a_ready(cur);
    if constexpr (SP2) {
        PG8_STAGE(PG8_SB(0, 0), cB, voffB); PG8_STAGE(PG8_SB(0, 1), cB + hstep, voffB); PG8_STAGE(PG8_SA(0, 0), cA, voffA); PG8_STAGE(PG8_SA(0, 1), cA + hstep, voffA);
        if (wr == 1) PG8_BAR;
        PG8_WAIT_V(2); PG8_BAR;
        PG8_STAGE(PG8_SB(1, 0), cB + kstep, voffB); PG8_STAGE(PG8_SA(1, 0), cA + kstep, voffA); PG8_STAGE(PG8_SB(1, 1), cB + hstep + kstep, voffB);
        PG8_WAIT_V(6); PG8_BAR;
    } else {
        PG8_STAGE(PG8_SB(0, 0), cB, voffB); PG8_STAGE(PG8_SA(0, 0), cA, voffA); PG8_STAGE(PG8_SB(0, 1), cB + hstep, voffB); PG8_STAGE(PG8_SA(0, 1), cA + hstep, voffA);
        if (wr == 1) PG8_BAR;
        PG8_WAIT_V(4); PG8_BAR;
        PG8_STAGE(PG8_SB(1, 0), cB + kstep, voffB); PG8_STAGE(PG8_SA(1, 0), cA + kstep, voffA); PG8_STAGE(PG8_SB(1, 1), cB + hstep + kstep, voffB);
        PG8_WAIT_V(6); PG8_BAR;
    }
    for (;;) {
        const bool has_next = S.next(ui + 1, nxt);
        const char* nA = has_next ? (const char*)g.A + (size_t)nxt.pm * tstep : cA; const char* nB = has_next ? (const char*)g.Bt + (size_t)nxt.pn * tstep : cB;
        for (int t = 0; t < nt; t += 2) {
            const bool last = (t == nt - 2);
            const char* a1 = cA + (size_t)(t + 1) * kstep;
            const char* a2 = last ? nA : cA + (size_t)(t + 2) * kstep; const char* b2 = last ? nB : cB + (size_t)(t + 2) * kstep;
            const char* a3 = a2 + kstep; const char* b3 = b2 + kstep;
            if (last && has_next) S.a_ready(nxt);
            if constexpr (SP2) {
            PG8_LDB(B0, 0, 0); PG8_LDB(B1, 0, 1); PG8_SCHED; PG8_LDA(At, 0, 0); PG8_STAGE(PG8_SA(1, 1), a1 + hstep, voffA);
            PG8_WAIT_V(8); PG8_WAIT_L(0); PG8_BAR; PG8_MMA(0, 0, At, B0); PG8_MMA(0, 1, At, B1); PG8_BAR; PG8_SCHED;
            PG8_LDA(At, 0, 1); PG8_STAGE(PG8_SB(0, 0), b2, voffB); PG8_STAGE(PG8_SB(0, 1), b2 + hstep, voffB); PG8_STAGE(PG8_SA(0, 0), a2, voffA);
            PG8_WAIT_V(8); PG8_WAIT_L(0); PG8_BAR; PG8_MMA(1, 0, At, B0); PG8_MMA(1, 1, At, B1); PG8_BAR; PG8_SCHED;
            PG8_LDB(B0, 1, 0); PG8_LDB(B1, 1, 1); PG8_SCHED; PG8_LDA(At, 1, 0); PG8_STAGE(PG8_SA(0, 1), a2 + hstep, voffA);
            PG8_WAIT_V(8); PG8_WAIT_L(0); PG8_BAR; PG8_MMA(0, 0, At, B0); PG8_MMA(0, 1, At, B1); PG8_BAR; PG8_SCHED;
            PG8_LDA(At, 1, 1); PG8_STAGE(PG8_SB(1, 0), b3, voffB); PG8_STAGE(PG8_SB(1, 1), b3 + hstep, voffB); PG8_STAGE(PG8_SA(1, 0), a3, voffA);
            PG8_WAIT_V(8); PG8_WAIT_L(0); PG8_BAR; PG8_MMA(1, 0, At, B0); PG8_MMA(1, 1, At, B1); PG8_BAR; PG8_SCHED;
            } else {
            PG8_LDB(B0, 0, 0); PG8_SCHED; PG8_LDA(At, 0, 0); PG8_STAGE(PG8_SA(1, 1), a1 + hstep, voffA);
            PG8_WAIT_L(8); PG8_BAR; PG8_WAIT_L(0); PG8_MMA(0, 0, At, B0); PG8_BAR; PG8_SCHED;
            PG8_LDB(B1, 0, 1); PG8_STAGE(PG8_SB(0, 0), b2, voffB);
            PG8_BAR; PG8_WAIT_L(0); PG8_MMA(0, 1, At, B1); PG8_BAR;
            PG8_LDA(At, 0, 1); PG8_STAGE(PG8_SA(0, 0), a2, voffA);
            PG8_BAR; PG8_WAIT_L(0); PG8_MMA(1, 0, At, B0); PG8_BAR; PG8_SCHED;
            PG8_STAGE(PG8_SB(0, 1), b2 + hstep, voffB);
            PG8_WAIT_V(6); PG8_BAR; PG8_MMA(1, 1, At, B1); PG8_BAR;
            PG8_LDB(B0, 1, 0); PG8_SCHED; PG8_LDA(At, 1, 0); PG8_STAGE(PG8_SA(0, 1), a2 + hstep, voffA);
            PG8_WAIT_L(8); PG8_BAR; PG8_WAIT_L(0); PG8_MMA(0, 0, At, B0); PG8_BAR; PG8_SCHED;
            PG8_LDB(B1, 1, 1); PG8_STAGE(PG8_SB(1, 0), b3, voffB);
            PG8_BAR; PG8_WAIT_L(0); PG8_MMA(0, 1, At, B1); PG8_BAR;
            PG8_LDA(At, 1, 1); PG8_STAGE(PG8_SA(1, 0), a3, voffA);
            PG8_BAR; PG8_WAIT_L(0); PG8_MMA(1, 0, At, B0); PG8_BAR; PG8_SCHED;
            PG8_STAGE(PG8_SB(1, 1), b3 + hstep, voffB);
            PG8_WAIT_V(6); PG8_BAR; PG8_MMA(1, 1, At, B1); PG8_BAR;
            }
        }
        if constexpr (ALIGN_EPI) { if (wr == 0) PG8_BAR; }
        if constexpr (!Epi::AFTER_DRAIN) { E(acc, cur, wr, wc, fr, fq); if (has_next) E.prefetch(nxt, wid, lane); S.done(cur); }
        if (!has_next) break;
#pragma unroll
        for (int a = 0; a < 2; ++a)
#pragma unroll
            for (int b = 0; b < 2; ++b)
#pragma unroll
                for (int m = 0; m < 4; ++m)
#pragma unroll
                    for (int n = 0; n < 2; ++n) acc[a][b][m][n] = (f32x4){0.f, 0.f, 0.f, 0.f};
        cur = nxt; cA = nA; cB = nB; ++ui;
        if constexpr (ALIGN_EPI) { if (wr == 1) PG8_BAR; }
    }
    PG8_WAIT_V(0);
    if constexpr (!ALIGN_EPI) { if (wr == 0) PG8_BAR; }
    PG8_BAR;
    if constexpr (Epi::AFTER_DRAIN) { E.fused(acc, cur, wr, wc, fr, fq, lds, wid, lane); S.done(cur); }
#undef PG8_SA
#undef PG8_SB
#undef PG8_STAGE
#undef PG8_LDA
#undef PG8_LDB
#undef PG8_MMA
#undef PG8_WAIT_V
#undef PG8_WAIT_L
#undef PG8_BAR
#undef PG8_SCHED
}
}

#define FC_AS3 __attribute__((address_space(3)))
#if defined(__HIP_DEVICE_COMPILE__)
#define FC_SINCOS(rev, s, c) do { (s) = __builtin_amdgcn_sinf(rev); (c) = __builtin_amdgcn_cosf(rev); } while (0)
#define FC_OPAQUE(v) asm volatile("" : "+v"(v))
#else
#define FC_OPAQUE(v) do {} while (0)
#include <cmath>
#define FC_SINCOS(rev, s, c) do { (s) = sinf(6.283185307179586f * (rev)); (c) = cosf(6.283185307179586f * (rev)); } while (0)
#endif
#include <utility>
#ifndef FC_HD
#define FC_HD __host__ __device__ __forceinline__
#endif
namespace fc {
typedef float cpx __attribute__((ext_vector_type(2)));
typedef float f4 __attribute__((ext_vector_type(4)));
#ifndef FC_AS3
#define FC_AS3
#endif
typedef FC_AS3 cpx* lptr;
typedef const FC_AS3 cpx* clptr;
FC_HD cpx cmul_c(cpx a, cpx b) { return cpx{a.x * b.x - a.y * b.y, a.x * b.y + a.y * b.x}; }
#if defined(__HIP_DEVICE_COMPILE__) && defined(FC_ASM_CMUL)
__device__ __forceinline__ cpx cmul(cpx a, cpx b) { cpx t, r;
    asm("v_pk_mul_f32 %0, %2, %3 op_sel:[1,1] op_sel_hi:[1,0]\n\tv_pk_fma_f32 %1, %2, %3, %0 op_sel:[0,0,0] op_sel_hi:[0,1,1] neg_lo:[0,0,1] neg_hi:[0,0,0]" : "=&v"(t), "=&v"(r) : "v"(a), "v"(b));
    return r; }
#else
FC_HD cpx cmul(cpx a, cpx b) { return cmul_c(a, b); }
#endif
#if defined(__HIP_DEVICE_COMPILE__) && defined(FC_ASM_CMULK)
__device__ __forceinline__ cpx cmul_k(cpx a, cpx b) { cpx t, r;
    asm("v_pk_mul_f32 %0, %2, %3 op_sel:[1,1] op_sel_hi:[1,0]\n\tv_pk_fma_f32 %1, %2, %3, %0 op_sel:[0,0,0] op_sel_hi:[0,1,1] neg_lo:[0,0,1] neg_hi:[0,0,0]" : "=&v"(t), "=&v"(r) : "v"(a), "v"(b));
    return r; }
#else
FC_HD cpx cmul_k(cpx a, cpx b) { return cmul_c(a, b); }
#endif
FC_HD cpx cadd(cpx a, cpx b) { return cpx{a.x + b.x, a.y + b.y}; }
FC_HD cpx csub(cpx a, cpx b) { return cpx{a.x - b.x, a.y - b.y}; }
FC_HD cpx cconj(cpx a) { return cpx{a.x, -a.y}; }
FC_HD constexpr int padi(int e) { return e + (e >> 4); }
FC_HD constexpr float c32(int m) {
    switch (m) { case 0: return 1.0f; case 1: return 0.98078528040323043f; case 2: return 0.92387953251128674f; case 3: return 0.83146961230254524f; case 4: return 0.70710678118654752f;
        case 5: return 0.55557023301960218f; case 6: return 0.38268343236508977f; case 7: return 0.19509032201612825f; case 8: return 0.0f; case 9: return -0.19509032201612825f;
        case 10: return -0.38268343236508977f; case 11: return -0.55557023301960218f; case 12: return -0.70710678118654752f; case 13: return -0.83146961230254524f; case 14: return -0.92387953251128674f;
        default: return -0.98078528040323043f; } }
FC_HD constexpr float s32(int m) {
    switch (m) { case 0: return 0.0f; case 1: return 0.19509032201612825f; case 2: return 0.38268343236508977f; case 3: return 0.55557023301960218f; case 4: return 0.70710678118654752f;
        case 5: return 0.83146961230254524f; case 6: return 0.92387953251128674f; case 7: return 0.98078528040323043f; case 8: return 1.0f; case 9: return 0.98078528040323043f;
        case 10: return 0.92387953251128674f; case 11: return 0.83146961230254524f; case 12: return 0.70710678118654752f; case 13: return 0.55557023301960218f; case 14: return 0.38268343236508977f;
        default: return 0.19509032201612825f; } }
template <int R> FC_HD constexpr int brev(int v) { int r = 0; for (int b = 1; b < R; b <<= 1) { r = (r << 1) | (v & 1); v >>= 1; } return r; }
template <int R, bool INV, int H, int P, bool ZU> FC_HD void dft_bfly(cpx (&c)[R]) {
    constexpr int blk = (P / H) * 2 * H, i = P % H, m = i * (16 / H);
    const cpx a = c[blk + i];
    cpx d;
    if constexpr (ZU && H == R / 2) d = a;
    else { const cpx b = c[blk + i + H]; c[blk + i] = cadd(a, b);
#if defined(__HIP_DEVICE_COMPILE__) && defined(FC_ASM_CMUL)
        if constexpr (m == 8) {
            cpx r;
            if (INV) asm("v_pk_add_f32 %0, %1, %2 op_sel:[1,1] op_sel_hi:[0,0] neg_lo:[1,0] neg_hi:[0,1]" : "=v"(r) : "v"(a), "v"(b));
            else     asm("v_pk_add_f32 %0, %1, %2 op_sel:[1,1] op_sel_hi:[0,0] neg_lo:[0,1] neg_hi:[1,0]" : "=v"(r) : "v"(a), "v"(b));
            c[blk + i + H] = r; return; }
#endif
        d = csub(a, b); }
    if constexpr (m == 0) c[blk + i + H] = d;
    else if constexpr (m == 8) c[blk + i + H] = INV ? cpx{-d.y, d.x} : cpx{d.y, -d.x};
    else { constexpr float wc = c32(m), ws = INV ? s32(m) : -s32(m); c[blk + i + H] = cmul_k(d, cpx{wc, ws}); }
}
template <int R, bool INV, int H, bool ZU, int... Ps> FC_HD void dft_stage(cpx (&c)[R], std::integer_sequence<int, Ps...>) { (dft_bfly<R, INV, H, Ps, ZU>(c), ...); }
template <int R, bool INV, int H, bool ZU> FC_HD void dft_stages(cpx (&c)[R]) {
    dft_stage<R, INV, H, ZU>(c, std::make_integer_sequence<int, R / 2>{});
    if constexpr (H > 1) dft_stages<R, INV, H / 2, ZU>(c);
}
template <int R, bool INV, bool ZU = false> FC_HD void dft_reg(cpx (&c)[R]) { dft_stages<R, INV, R / 2, ZU>(c); }
template <int M, int S, int R, bool INV, int NT, int ZH = 0, bool WM = false> FC_HD void fft_pass(lptr lds, int tid) {
    constexpr int T = S / R, IT = (M / R) / NT;
    FC_OPAQUE(tid);
    for (int it = 0; it < (IT > 0 ? IT : 1); ++it) {
        const int b = WM ? (tid & ~63) * IT + (tid & 63) + 64 * it : tid + NT * it;
        if (b >= M / R) break;
        const int j = b % T, blk = b / T, base = blk * S + j;
        static_assert(T % 16 == 0 || (T == 1 && R <= 16), "padded index must be linear in k");
        constexpr int TS = (T % 16 == 0) ? T + T / 16 : 1;
        const int pb = padi(base);
        cpx c[R];
#pragma unroll
        for (int k = 0; k < R; ++k) { if (ZH == 1 && k >= R / 2) c[k] = cpx{0.f, 0.f}; else c[k] = lds[pb + k * TS]; }
        cpx w1 = cpx{1.f, 0.f};
        if (T > 1) { float s, co; FC_SINCOS((float)j * (1.0f / (float)S), s, co); w1 = cpx{co, INV ? s : -s}; }
        cpx w4 = cpx{1.f, 0.f}, cur[4];
        if (T > 1) { const cpx w2 = cmul_c(w1, w1); cur[0] = cpx{1.f, 0.f}; cur[1] = w1; cur[2] = w2; cur[3] = cmul_c(w2, w1); w4 = cmul_c(w2, w2); }
        if (INV && T > 1) {
#pragma unroll
            for (int k0 = 0; k0 < R; k0 += 4) {
#pragma unroll
                for (int i = 0; i < 4; ++i) { if (k0 + i > 0) c[k0 + i] = cmul(c[k0 + i], cur[i]); if (k0 + 4 < R) cur[i] = cmul(cur[i], w4); }
            }
        }
        dft_reg<R, INV, ZH == 1>(c);
        if (!INV && T > 1) {
#pragma unroll
            for (int k0 = 0; k0 < R; k0 += 4) {
#pragma unroll
                for (int i = 0; i < 4; ++i) { if (k0 + i > 0) c[brev<R>(k0 + i)] = cmul(c[brev<R>(k0 + i)], cur[i]); if (k0 + 4 < R) cur[i] = cmul(cur[i], w4); }
            }
        }
#pragma unroll
        for (int k = 0; k < (ZH == 2 ? R / 2 : R); ++k) lds[pb + k * TS] = c[brev<R>(k)];
    }
}
template <int M> struct Radix;
template <> struct Radix<8192>  { static constexpr int R1 = 32, R2 = 16, R3 = 16; };
template <> struct Radix<16384> { static constexpr int R1 = 32, R2 = 32, R3 = 16; };
template <int M> FC_HD int fpos(int f) { typedef Radix<M> X; return (f % X::R1) * (M / X::R1) + ((f / X::R1) % X::R2) * X::R3 + (f / (X::R1 * X::R2)); }
template <int M> FC_HD int qfreq(int q) { typedef Radix<M> X; const int k3 = q % (X::R3 / 2), k2 = (q / (X::R3 / 2)) % X::R2, k1 = q / ((X::R3 / 2) * X::R2); return k1 + X::R1 * (k2 + X::R2 * k3); }

#if defined(__HIP_DEVICE_COMPILE__)
#define FC_WSYNC asm volatile("s_waitcnt lgkmcnt(0)" ::: "memory")
#else
#define FC_WSYNC do {} while (0)
#endif
#define FC_FWD(M, NT, lds, tid, SYNC) do { typedef fc::Radix<M> X_; fc::fft_pass<M, M, X_::R1, false, NT>(lds, tid); SYNC; fc::fft_pass<M, M / X_::R1, X_::R2, false, NT, 0, true>(lds, tid); FC_WSYNC; \
    fc::fft_pass<M, X_::R3, X_::R3, false, NT, 0, true>(lds, tid); SYNC; } while (0)
#define FC_FWD12Z(M, NT, lds, tid, SYNC) do { typedef fc::Radix<M> X_; fc::fft_pass<M, M, X_::R1, false, NT, 1>(lds, tid); SYNC; fc::fft_pass<M, M / X_::R1, X_::R2, false, NT, 0, true>(lds, tid); FC_WSYNC; } while (0)
#define FC_FWD3(M, NT, lds, tid, SYNC) do { typedef fc::Radix<M> X_; fc::fft_pass<M, X_::R3, X_::R3, false, NT, 0, true>(lds, tid); SYNC; } while (0)
#define FC_INVZ(M, NT, lds, tid, SYNC) do { typedef fc::Radix<M> X_; fc::fft_pass<M, X_::R3, X_::R3, true, NT, 0, true>(lds, tid); FC_WSYNC; fc::fft_pass<M, M / X_::R1, X_::R2, true, NT, 0, true>(lds, tid); SYNC; \
    fc::fft_pass<M, M, X_::R1, true, NT, 2>(lds, tid); SYNC; } while (0)

#if defined(__HIP_DEVICE_COMPILE__) && defined(FC_ASM_CMUL)
__device__ __forceinline__ void untangle(cpx Zf, cpx Zg, cpx w, cpx& Xf, cpx& Xg) {
    cpx A, D, t, u;
    asm("v_pk_add_f32 %0, %6, %7 neg_hi:[0,1]\n\t"
        "v_pk_add_f32 %1, %6, %7 neg_lo:[0,1]\n\t"
        "v_pk_mul_f32 %2, %8, %1 op_sel:[1,1] op_sel_hi:[1,0]\n\t"
        "v_pk_fma_f32 %3, %8, %1, %2 op_sel:[0,0,0] op_sel_hi:[0,1,1] neg_lo:[0,0,1] neg_hi:[0,0,0]\n\t"
        "v_pk_add_f32 %4, %0, %3 op_sel:[0,1] op_sel_hi:[1,0] neg_hi:[0,1]\n\t"
        "v_pk_add_f32 %5, %0, %3 op_sel:[0,1] op_sel_hi:[1,0] neg_lo:[0,1] neg_hi:[1,1]"
        : "=&v"(A), "=&v"(D), "=&v"(t), "=&v"(u), "=&v"(Xf), "=&v"(Xg) : "v"(Zf), "v"(Zg), "v"(w));
}
__device__ __forceinline__ void retangle(cpx Yf, cpx Yg, cpx w, cpx& Zf, cpx& Zg) {
    cpx P, D, t, u;
    asm("v_pk_add_f32 %0, %6, %7 neg_hi:[0,1]\n\t"
        "v_pk_add_f32 %1, %6, %7 neg_lo:[0,1]\n\t"
        "v_pk_mul_f32 %2, %1, %8 op_sel:[1,1] op_sel_hi:[0,1]\n\t"
        "v_pk_fma_f32 %3, %1, %8, %2 op_sel:[0,0,0] op_sel_hi:[1,0,1] neg_lo:[0,0,0] neg_hi:[0,0,1]\n\t"
        "v_pk_add_f32 %4, %0, %3 op_sel:[0,1] op_sel_hi:[1,0] neg_lo:[0,1]\n\t"
        "v_pk_add_f32 %5, %0, %3 op_sel:[0,1] op_sel_hi:[1,0] neg_hi:[1,0]"
        : "=&v"(P), "=&v"(D), "=&v"(t), "=&v"(u), "=&v"(Zf), "=&v"(Zg) : "v"(Yf), "v"(Yg), "v"(w));
}
#else
FC_HD void untangle(cpx Zf, cpx Zg, cpx w, cpx& Xf, cpx& Xg) {
    const cpx A = cpx{Zf.x + Zg.x, Zf.y - Zg.y}, D = cpx{Zf.x - Zg.x, Zf.y + Zg.y};
    const cpx t = cmul_c(w, D);
    Xf = cpx{A.x + t.y, A.y - t.x}; Xg = cpx{A.x - t.y, -A.y - t.x};
}
FC_HD void retangle(cpx Yf, cpx Yg, cpx w, cpx& Zf, cpx& Zg) {
    const cpx P = cpx{Yf.x + Yg.x, Yf.y - Yg.y}, D = cpx{Yf.x - Yg.x, Yf.y + Yg.y};
    const cpx u = cpx{D.x * w.x + D.y * w.y, D.y * w.x - D.x * w.y};
    Zf = cpx{P.x - u.y, P.y + u.x}; Zg = cpx{P.x + u.y, -P.y + u.x};
}
#endif
template <int M> FC_HD cpx wstep() { return M == 8192 ? cpx{0.9999997058628822f, -0.0007669903187427045f} : cpx{0.9999999264657179f, -0.00038349518757139556f}; }
template <int M, int NT> struct PairIdx {
    typedef Radix<M> X;
    static constexpr int NJ = (M / 2) / NT, PS = 2 * (M / X::R1), PSP = PS + PS / 16;
    static_assert(NT == (X::R3 / 2) * X::R2 * 2, "thread count vs radix split");
    int f0, pf0, pg0, pgA;
    FC_HD void init(int tid) {
        const int k3 = tid % (X::R3 / 2), k2 = (tid / (X::R3 / 2)) % X::R2, k1b = tid / ((X::R3 / 2) * X::R2);
        f0 = k1b + X::R1 * (k2 + X::R2 * k3);
        pf0 = padi(k1b * (M / X::R1) + k2 * X::R3 + k3);
        pg0 = padi(fpos<M>((M - f0) % M));
        pgA = padi((X::R1 - k1b) * (M / X::R1) + (X::R2 - 1 - k2) * X::R3 + (X::R3 - 1 - k3));
    }
    FC_HD int pf(int jj) const { return pf0 + jj * PSP; }
    FC_HD int pg(int jj) const { return jj == 0 ? pg0 : pgA - jj * PSP; }
};
template <int M, int NT> FC_HD void filter_pass(clptr lds, int tid, float sc, f4* kb) {
    FC_OPAQUE(tid);
    PairIdx<M, NT> ix; ix.init(tid);
    float s, co; FC_SINCOS((float)ix.f0 * (0.5f / (float)M), s, co); cpx w = cpx{co, -s}; const cpx d = wstep<M>();
#pragma unroll
    for (int jj = 0; jj < PairIdx<M, NT>::NJ; ++jj) {
        const cpx Zf = lds[ix.pf(jj)], Zg = lds[ix.pg(jj)];
        cpx Xf, Xg; untangle(Zf, Zg, w, Xf, Xg);
        kb[jj * NT + tid] = f4{Xf.x * sc, Xf.y * sc, Xg.x * sc, Xg.y * sc};
        w = cmul_c(w, d);
    }
    if (tid == 0) { const cpx Z = lds[padi(fpos<M>(M / 2))]; cpx Xf, Xg; untangle(Z, Z, cpx{0.f, -1.f}, Xf, Xg);
        kb[M / 2] = f4{Xf.x * sc, Xf.y * sc, Xg.x * sc, Xg.y * sc}; }
}
template <int M, int NT> struct KRegs { f4 k[(M / 2) / NT]; f4 kx; };
template <int M, int NT> FC_HD void k_prefetch(const f4* kb, int tid, KRegs<M, NT>& r) {
#pragma unroll
    for (int jj = 0; jj < (M / 2) / NT; ++jj) r.k[jj] = kb[jj * NT + tid];
    r.kx = kb[M / 2];
}
template <int M, int NT> FC_HD void mult_pass(lptr lds, int tid, const KRegs<M, NT>& r) {
    FC_OPAQUE(tid);
    PairIdx<M, NT> ix; ix.init(tid);
    float s, co; FC_SINCOS((float)ix.f0 * (0.5f / (float)M), s, co); cpx w = cpx{co, -s}; const cpx d = wstep<M>();
#pragma unroll
    for (int jj = 0; jj < PairIdx<M, NT>::NJ; ++jj) {
        const int pf = ix.pf(jj), pg = ix.pg(jj);
        const cpx Zf = lds[pf], Zg = lds[pg];
        cpx Xf, Xg; untangle(Zf, Zg, w, Xf, Xg);
        const f4 k = r.k[jj];
        const cpx Yf = cmul(Xf, cpx{k[0], k[1]}), Yg = cmul(Xg, cpx{k[2], k[3]});
        cpx Of, Og; retangle(Yf, Yg, w, Of, Og);
        lds[pf] = Of; if (jj != 0 || ix.f0 != 0) lds[pg] = Og;
        w = cmul_c(w, d);
    }
    if (tid == 0) { const int p = padi(fpos<M>(M / 2)); const cpx Z = lds[p]; const cpx w2 = cpx{0.f, -1.f}; cpx Xf, Xg; untangle(Z, Z, w2, Xf, Xg);
        const f4 k = r.kx; const cpx Yf = cmul(Xf, cpx{k[0], k[1]}), Yg = cmul(Xg, cpx{k[2], k[3]}); cpx Of, Og; retangle(Yf, Yg, w2, Of, Og); lds[p] = Of; }
}
}

constexpr int NWAVES = 8;
constexpr int D = 2048, NTOK = 49152, NTOKP = 32768, LP = 8192, LS = 16384, NBP = 4;
constexpr int DFF = 5632, NGU = 2 * DFF, NQKV = 3072, NHY = 3 * D;
constexpr int HT_ROWS = 8192, HT_COLS = LP + LS;
constexpr int NHEAD = 16, HD = 128, NKV = 4;
constexpr float EPS = 1e-6f;
#ifndef MK_PER_PHASE
#define MK_PER_PHASE 0
#endif
constexpr int NPHASE = 23;
#ifndef EN_MASK
#define EN_MASK 0xffff
#endif

constexpr size_t MiB = 1u << 20;
constexpr size_t WS_CTL = 0, CTL_ZERO_BYTES = 64 * 1024;
constexpr size_t WS_RSS = 1 * MiB;
constexpr size_t WS_WMA = 4 * MiB;
constexpr size_t WS_WMB = 28 * MiB;
constexpr size_t WS_WGU = 36 * MiB;
constexpr size_t WS_WDN = 80 * MiB;
constexpr size_t WS_A3X = 102 * MiB;
constexpr size_t WS_WOX = 126 * MiB;
constexpr size_t WS_XN = 134 * MiB;
constexpr size_t WS_HT = 326 * MiB;
constexpr size_t WS_BIG = 710 * MiB;
constexpr size_t WS_KB = 1286 * MiB;
constexpr int KB_ORDER = 8256;
constexpr int KB_BLOCK = 2 * KB_ORDER + 4096;
constexpr size_t WS_END = WS_KB + (size_t)256 * KB_BLOCK * 16;
static_assert(WS_END <= 1400 * MiB, "ws map");
constexpr int CW_BAR = 4096;

constexpr int LDS_BYTES = 147456;
constexpr int MISC_OFF = 146432;
constexpr int RED_OFF = 145408;
constexpr int PTAB_OFF = MISC_OFF + 256;

typedef __attribute__((address_space(3))) float pg8_las_f;
#define GAS __attribute__((address_space(1)))
#define LAS __attribute__((address_space(3)))
typedef unsigned short bf16;
typedef unsigned v4u __attribute__((ext_vector_type(4)));
typedef unsigned v2u __attribute__((ext_vector_type(2)));
typedef float f32x4 __attribute__((ext_vector_type(4)));
typedef float f32x16 __attribute__((ext_vector_type(16)));
typedef short bf16x8 __attribute__((ext_vector_type(8)));
typedef short s16x4 __attribute__((ext_vector_type(4)));
typedef GAS unsigned gu32;
#define RLX_AGENT __ATOMIC_RELAXED, __HIP_MEMORY_SCOPE_AGENT
#define LDS_WAIT() asm volatile("s_waitcnt lgkmcnt(0)" ::: "memory")
__device__ __forceinline__ unsigned f2bf(float f) { unsigned u = __builtin_bit_cast(unsigned, f); return (u + 0x7fffu + ((u >> 16) & 1u)) >> 16; }
__device__ __forceinline__ unsigned pk2(float lo, float hi) { unsigned r; asm("v_cvt_pk_bf16_f32 %0, %1, %2" : "=v"(r) : "v"(lo), "v"(hi)); return r; }
__device__ __forceinline__ float bf_lo(unsigned w) { return __builtin_bit_cast(float, w << 16); }
__device__ __forceinline__ float bf_hi(unsigned w) { return __builtin_bit_cast(float, w & 0xffff0000u); }
__device__ __forceinline__ float h2f(unsigned short h) { return (float)__builtin_bit_cast(_Float16, h); }
__device__ __forceinline__ float dpp_f(float v, int ctrl_sel) {
    const int b = __builtin_bit_cast(int, v); int r;
    if (ctrl_sel == 0) r = __builtin_amdgcn_update_dpp(0, b, 0xB1, 0xF, 0xF, true);
    else if (ctrl_sel == 1) r = __builtin_amdgcn_update_dpp(0, b, 0x4E, 0xF, 0xF, true);
    else if (ctrl_sel == 2) r = __builtin_amdgcn_update_dpp(0, b, 0x141, 0xF, 0xF, true);
    else r = __builtin_amdgcn_update_dpp(0, b, 0x140, 0xF, 0xF, true);
    return __builtin_bit_cast(float, r);
}
__device__ __forceinline__ float sum16(float v) { v += dpp_f(v, 0); v += dpp_f(v, 1); v += dpp_f(v, 2); v += dpp_f(v, 3); return v; }
__device__ __forceinline__ float sum_halves(float v) { const unsigned u = __builtin_bit_cast(unsigned, v); const auto rr = __builtin_amdgcn_permlane32_swap(u, u, false, false);
    return __builtin_bit_cast(float, (unsigned)rr[0]) + __builtin_bit_cast(float, (unsigned)rr[1]); }
__device__ __forceinline__ float max_halves(float v) { const unsigned u = __builtin_bit_cast(unsigned, v); const auto rr = __builtin_amdgcn_permlane32_swap(u, u, false, false);
    return fmaxf(__builtin_bit_cast(float, (unsigned)rr[0]), __builtin_bit_cast(float, (unsigned)rr[1])); }
__device__ __forceinline__ float rdlane_f(float v, int l) { return __builtin_bit_cast(float, __builtin_amdgcn_readlane(__builtin_bit_cast(int, v), l)); }
__device__ __forceinline__ float wave_sum(float v, int  ) { v = sum16(v); return (rdlane_f(v, 0) + rdlane_f(v, 16)) + (rdlane_f(v, 32) + rdlane_f(v, 48)); }

#define XB_TMO      128
#define XB_XCNT(j)  (256  + 64 * (j))
#define XB_XSUB(j)  (1280 + 64 * (j))
#define XB_XGEN(j)  (2304 + 64 * (j))
#define XB_TOP      3328
#define XB_TOPGEN   3392
#define XCD_BAR_WORDS 3456
#define XB_SPIN_CAP (1u << 18)

__device__ __forceinline__ unsigned xb_ld(unsigned* p)              { return __hip_atomic_load(p, __ATOMIC_RELAXED, __HIP_MEMORY_SCOPE_AGENT); }
__device__ __forceinline__ unsigned xb_add(unsigned* p, unsigned v) { return __hip_atomic_fetch_add(p, v, __ATOMIC_RELAXED, __HIP_MEMORY_SCOPE_AGENT); }
__device__ __forceinline__ unsigned xb_xcc_id() { return (unsigned)__builtin_amdgcn_s_getreg((3 << 11) | 20) & 0xFu; }
#define XB_SPIN(cond, bar) do { unsigned _sp = 0; while (cond) { __builtin_amdgcn_s_sleep(1); \
    if ((++_sp & 255u) == 0u) { if (xb_ld(&(bar)[XB_TMO])) break; if (_sp > XB_SPIN_CAP) { atomicAdd(&(bar)[XB_TMO], 1u); break; } } } } while (0)

struct XcdBarrier {
    unsigned* bar; unsigned x;
    volatile LAS unsigned* st;
};

__device__ __forceinline__ XcdBarrier xcd_barrier_post(unsigned* bar, volatile LAS unsigned* st) {
    XcdBarrier b; b.bar = bar; b.x = xb_xcc_id(); b.st = st;
    if (threadIdx.x == 0) (void)xb_add(&bar[XB_XCNT(b.x)], 1u);
    return b;
}
__device__ __forceinline__ void xcd_barrier_complete(unsigned* bar, unsigned x, unsigned& nloc, unsigned& nx) {
    const unsigned G = gridDim.x * gridDim.y * gridDim.z;
    unsigned sum, cnt, mine, sp = 0u;
    for (;;) {
        sum = 0u; cnt = 0u; mine = 0u;
#pragma unroll
        for (unsigned j = 0; j < 16; ++j) { const unsigned c = xb_ld(&bar[XB_XCNT(j)]); sum += c; cnt += (c > 0u) ? 1u : 0u; mine = (j == x) ? c : mine; }
        if (sum == G) break;
        __builtin_amdgcn_s_sleep(1);
        if ((++sp & 255u) == 0u) { if (xb_ld(&bar[XB_TMO])) break; if (sp > XB_SPIN_CAP) { atomicAdd(&bar[XB_TMO], 1u); break; } }
    }
    nloc = mine > 0u ? mine : 1u; nx = cnt > 0u ? cnt : 1u;
}

__device__ __forceinline__ void xcd_barrier(const XcdBarrier& b) {
    asm volatile("s_waitcnt vmcnt(0)" ::: "memory");
    __syncthreads();
    if (threadIdx.x == 0) {
        unsigned* bar = b.bar;
        __builtin_amdgcn_s_waitcnt(0);
        unsigned nloc = b.st[0], nx = b.st[1];
        if (nloc == 0u) { xcd_barrier_complete(bar, b.x, nloc, nx); b.st[0] = nloc; b.st[1] = nx; }
        const unsigned old = xb_add(&bar[XB_XSUB(b.x)], 1u);
        const unsigned gen = old / nloc;
        if (old + 1u == (gen + 1u) * nloc) {
            __builtin_amdgcn_fence(__ATOMIC_RELEASE, "agent");
            asm volatile("s_waitcnt vmcnt(0)" ::: "memory");
            const unsigned og = xb_add(&bar[XB_TOP], 1u);
            const unsigned tg = og / nx;
            if (og + 1u == (tg + 1u) * nx) xb_add(&bar[XB_TOPGEN], 1u);
            else XB_SPIN(xb_ld(&bar[XB_TOPGEN]) == tg, bar);
            __builtin_amdgcn_fence(__ATOMIC_ACQUIRE, "agent");
            xb_add(&bar[XB_XGEN(b.x)], 1u);
            asm volatile("s_waitcnt vmcnt(0)" ::: "memory");
        } else {
            XB_SPIN(xb_ld(&bar[XB_XGEN(b.x)]) == gen, bar);
            __builtin_amdgcn_fence(__ATOMIC_ACQUIRE, "agent");
            asm volatile("s_waitcnt vmcnt(0)" ::: "memory");
        }
    }
    __syncthreads();
}

struct Args {
    const float* in[27]; float* out; unsigned char* ws; int ph_lo, ph_hi, dry, pad;
};
struct Frame {
    LAS unsigned char* lds;
    int tid, lane, wave, vcu, G, bx;
    __device__ __forceinline__ const float* inp(int i) const {
        volatile LAS unsigned* t = (volatile LAS unsigned*)(lds + PTAB_OFF) + 2 * i;
        const unsigned lo = __builtin_amdgcn_readfirstlane(t[0]), hi = __builtin_amdgcn_readfirstlane(t[1]);
        return (const float*)(const GAS float*)(((unsigned long long)hi << 32) | lo);
    }
    __device__ __forceinline__ float* outp() const { return (float*)inp(27); }
    __device__ __forceinline__ unsigned char* wsp() const { return (unsigned char*)inp(28); }
};
#define OPAQUE_V(v) asm volatile("" : "+v"(v))
#define OPAQUE_S(v) asm volatile("" : "+s"(v))
#define PH_FRAME(Fp) Frame Fp = F; OPAQUE_S(Fp.lds); OPAQUE_S(Fp.wave); OPAQUE_S(Fp.vcu); OPAQUE_S(Fp.G); OPAQUE_S(Fp.bx); asm volatile("v_mbcnt_lo_u32_b32 %0, -1, 0\n\tv_mbcnt_hi_u32_b32 %0, -1, %0" : "=v"(Fp.lane)); Fp.tid = Fp.wave * 64 + Fp.lane

struct CvtRegs { float w[32]; f32x4 g0, g1; };
__device__ __forceinline__ void cvt_load(const float* W, const float* gain, int N, int item, int lane, CvtRegs& r) {
    const int nblk = N / 32, kb = item / nblk, nb = item % nblk, k0 = 64 * kb, n0 = 32 * nb;
    if (gain) { r.g0 = *(const GAS f32x4*)(gain + k0 + 8 * (lane & 7)); r.g1 = *(const GAS f32x4*)(gain + k0 + 8 * (lane & 7) + 4); } else { r.g0 = (f32x4){1.f, 1.f, 1.f, 1.f}; r.g1 = r.g0; }
#pragma unroll
    for (int i = 0; i < 32; ++i) r.w[i] = W[(size_t)(k0 + 2 * i + (lane >> 5)) * N + n0 + (lane & 31)];
}
template <int MODE> __device__ __forceinline__ void cvt_store(const CvtRegs& r, int K, int N, bf16* WT, LAS float* scr, int item, int lane) {
    const int nblk = N / 32, kb = item / nblk, nb = item % nblk, k0 = 64 * kb, n0 = 32 * nb;
#pragma unroll
    for (int i = 0; i < 32; ++i) { const int kk = 2 * i + (lane >> 5); scr[kk * 33 + (lane & 31)] = r.w[i]; }
    LDS_WAIT(); asm volatile("" ::: "memory");
    const int c = lane & 7;
    int r0 = n0; if (MODE == 1) { const int half = n0 / DFF, rr = n0 % DFF; r0 = (rr / 128) * 256 + half * 128 + (rr % 128); }
#pragma unroll
    for (int j = 0; j < 4; ++j) { const int n = (lane >> 3) + 8 * j; const LAS float* s = scr + (8 * c) * 33 + n;
        v4u o; o.x = pk2(s[0 * 33] * r.g0.x, s[1 * 33] * r.g0.y); o.y = pk2(s[2 * 33] * r.g0.z, s[3 * 33] * r.g0.w); o.z = pk2(s[4 * 33] * r.g1.x, s[5 * 33] * r.g1.y); o.w = pk2(s[6 * 33] * r.g1.z, s[7 * 33] * r.g1.w);
        *(GAS v4u*)(WT + (size_t)(r0 + n) * K + k0 + 8 * c) = o; }
    LDS_WAIT(); asm volatile("" ::: "memory");
}
template <int MODE> __device__ __forceinline__ void cvt_weight(const Frame& F, const float* W, const float* gain, int K, int N, bf16* WT) {
    LAS float* scr = (LAS float*)(F.lds + F.wave * 8704);
    const int gw = F.vcu * NWAVES + F.wave, NGW = F.G * NWAVES, nitems = (K / 64) * (N / 32);
    CvtRegs cur, nxt;
    if (gw < nitems) cvt_load(W, gain, N, gw, F.lane, cur);
    for (int it = gw; it < nitems; it += NGW) {
        const bool more = it + NGW < nitems;
        if (more) cvt_load(W, gain, N, it + NGW, F.lane, nxt);
        cvt_store<MODE>(cur, K, N, WT, scr, it, F.lane);
        if (more) { cur.g0 = nxt.g0; cur.g1 = nxt.g1;
#pragma unroll
            for (int i = 0; i < 32; ++i) cur.w[i] = nxt.w[i]; }
    }
}
__device__ __forceinline__ void prep_rows(const Frame& F, const float* xa, const float* xb, bf16* XN, float* rss) {
    const int gw = F.vcu * NWAVES + F.wave, NGW = F.G * NWAVES;
    f32x4 v[8], nx[8];
    if (gw < NTOK) { const GAS f32x4* xr = (const GAS f32x4*)((gw < NTOKP) ? xa + (size_t)gw * D : xb + (size_t)(gw - NTOKP) * D) + F.lane;
#pragma unroll
        for (int j = 0; j < 8; ++j) nx[j] = xr[64 * j]; }
    for (int m = gw; m < NTOK; m += NGW) {
#pragma unroll
        for (int j = 0; j < 8; ++j) v[j] = nx[j];
        { const int mn = (m + NGW < NTOK) ? m + NGW : m;
          const GAS f32x4* xr = (const GAS f32x4*)((mn < NTOKP) ? xa + (size_t)mn * D : xb + (size_t)(mn - NTOKP) * D) + F.lane;
#pragma unroll
          for (int j = 0; j < 8; ++j) nx[j] = xr[64 * j]; }
        float s = 0.f;
#pragma unroll
        for (int j = 0; j < 8; ++j) {
            const float a = bf_lo(f2bf(v[j].x)), b = bf_lo(f2bf(v[j].y)), c = bf_lo(f2bf(v[j].z)), d = bf_lo(f2bf(v[j].w)); s += (a * a + b * b) + (c * c + d * d); }
        s = wave_sum(s, F.lane);
        if (F.lane < 8) rss[(size_t)m * 8 + F.lane] = (F.lane == 0) ? s : 0.f;
        GAS v2u* o = (GAS v2u*)(XN + (size_t)m * D) + F.lane;
#pragma unroll
        for (int j = 0; j < 8; ++j) { v2u w; w.x = pk2(v[j].x, v[j].y); w.y = pk2(v[j].z, v[j].w); o[64 * j] = w; }
    }
}
__device__ __forceinline__ float rdlane(float v, int k) { return __builtin_bit_cast(float, __builtin_amdgcn_readlane(__builtin_bit_cast(int, v), k)); }
__device__ __forceinline__ void filter_mlp(const Frame& F, bf16* A3X, bf16* WOX) {
    const int gw = F.vcu * NWAVES + F.wave, NGW = F.G * NWAVES, lane = F.lane;
    for (int it = gw; it < 2 * HT_COLS; it += NGW) {
        const int j = it / HT_COLS, ip = it % HT_COLS;
        const int L = ip < LP ? LP : LS, i = ip < LP ? ip : ip - LP;
        const float* w1 = F.inp(8) + (size_t)j * 33 * 64; const float* b1 = F.inp(9) + j * 64; const float* w2 = F.inp(10) + (size_t)j * 64 * 64; const float* b2 = F.inp(11) + j * 64;
        const float* w3 = F.inp(12) + (size_t)j * 64 * 64; const float* b3 = F.inp(13) + j * 64; const float fr = F.inp(15)[j * 64 + lane];
        const float t = (float)i / (float)(L - 1);
        const float wang = (6.2831853071795864769f * (float)i) / (float)L;
        float feat = 0.f;
        if (lane == 0) feat = t;
        else if (lane <= 32) { const int b = (lane - 1) & 15; const float fb = (float)(1e-4 + (double)b * ((15.0 - 1e-4) / 15.0)); const float ang = wang * fb; feat = (lane <= 16) ? cosf(ang) : -sinf(ang); }
        float acc = b1[lane];
#pragma unroll
        for (int k = 0; k < 33; ++k) acc += rdlane(feat, k) * w1[k * 64 + lane];
        float a = sinf(fr * acc);
        acc = b2[lane];
#pragma unroll 16
        for (int k = 0; k < 64; ++k) acc += rdlane(a, k) * w2[k * 64 + lane];
        a = sinf(fr * acc);
        acc = b3[lane];
#pragma unroll 16
        for (int k = 0; k < 64; ++k) acc += rdlane(a, k) * w3[k * 64 + lane];
        a = sinf(fr * acc);
        const unsigned hi = f2bf(a); const float rem = a - __builtin_bit_cast(float, hi << 16); const unsigned lo = f2bf(rem);
        bf16* o = A3X + (size_t)it * 256;
        o[lane] = (bf16)hi; o[64 + lane] = (bf16)lo; o[128 + lane] = (bf16)hi; o[192 + lane] = 0;
    }
    for (int it = gw; it < 2 * HT_ROWS; it += NGW) {
        const int j = it / HT_ROWS, col = it % HT_ROWS;
        const float w = F.inp(14)[((size_t)j * 64 + lane) * HT_ROWS + col];
        const unsigned hi = f2bf(w); const float rem = w - __builtin_bit_cast(float, hi << 16); const unsigned lo = f2bf(rem);
        bf16* o = WOX + (size_t)it * 256;
        o[lane] = (bf16)hi; o[64 + lane] = (bf16)hi; o[128 + lane] = (bf16)lo; o[192 + lane] = 0;
    }
}
struct Raw8 { v4u c; unsigned p, n; };
__device__ __forceinline__ Raw8 ld8(const unsigned* row, int q, int ngrp) {
    Raw8 r; r.c = *(const v4u*)(row + 4 * q);
    const int qm = q > 0 ? 4 * q - 1 : 0, qp = (q + 1 < ngrp) ? 4 * q + 4 : 0;
    r.p = row[qm]; r.n = row[qp]; r.p = q > 0 ? r.p : 0u; r.n = (q + 1 < ngrp) ? r.n : 0u; return r;
}
__device__ __forceinline__ void sconv8(const Raw8& r, float c0, float c1, float c2, float cb, fc::cpx (&o)[4]) {
    float u[10]; u[0] = bf_hi(r.p); u[9] = bf_lo(r.n);
#pragma unroll
    for (int e = 0; e < 4; ++e) { u[1 + 2 * e] = bf_lo(r.c[e]); u[2 + 2 * e] = bf_hi(r.c[e]); }
#pragma unroll
    for (int i = 0; i < 4; ++i) o[i] = fc::cpx{c0 * u[2 * i] + c1 * u[2 * i + 1] + c2 * u[2 * i + 2] + cb, c0 * u[2 * i + 1] + c1 * u[2 * i + 2] + c2 * u[2 * i + 3] + cb};
}
#define CONV_SYNC asm volatile("s_waitcnt lgkmcnt(0)\n\ts_barrier" ::: "memory")
#define CONV_SYNC_FULL __syncthreads()
#define RFL(x) __builtin_bit_cast(float, __builtin_amdgcn_readfirstlane(__builtin_bit_cast(int, (x))))
#define SC_LOAD(pre, col) const float pre##0 = RFL(cw[col]), pre##1 = RFL(cw[NHY + (col)]), pre##2 = RFL(cw[2 * NHY + (col)]), pre##b = RFL(cbp[col])
template <int M, int NT> __device__ __forceinline__ void conv_part(const Frame& F, int hj, int c, int nseq, int tok0, int hcol0, const unsigned short* HT, bf16* UT, bf16* ZO, fc::f4* kb) {
    constexpr int L = M, NG = (L / 8) / NT, NH = 512 / NT;
    const int hh = (NH == 2) ? (F.wave >> 2) : 0;
    int tl = F.tid & (NT - 1);
    fc::lptr lds = (fc::lptr)F.lds + hh * fc::padi(8192);
    LAS float* red = (LAS float*)(F.lds + RED_OFF);
#pragma unroll 1
    for (int oi = 0; oi < 2 / NH; ++oi) {
        const int o = (NH == 2) ? hh : oi;
        const unsigned short* hf = HT + (size_t)((o * 2 + 0) * D + c) * HT_COLS + hcol0;
        const unsigned short* hb = HT + (size_t)((o * 2 + 1) * D + c) * HT_COLS + hcol0;
        float part = 0.f;
        OPAQUE_V(tl);
        v4u raw[2 * NG]; unsigned short top[NG];
#pragma unroll
        for (int it = 0; it < 2 * NG; ++it) { const int q = tl + NT * it;
            if (it < NG) raw[it] = ((const v4u*)hf)[q];
            else { const int qp = q - L / 8; raw[it] = ((const v4u*)hb)[L / 8 - 1 - qp]; top[it - NG] = hb[qp > 0 ? L - 8 * qp : 0]; } }
#pragma unroll
        for (int it = 0; it < 2 * NG; ++it) { const int q = tl + NT * it;
            float t[8];
#pragma unroll
            for (int e = 0; e < 4; ++e) { t[2 * e] = h2f((unsigned short)(raw[it][e] & 0xffffu)); t[2 * e + 1] = h2f((unsigned short)(raw[it][e] >> 16)); }
            fc::cpx o4[4];
            if (it < NG) { o4[0] = fc::cpx{t[0], t[1]}; o4[1] = fc::cpx{t[2], t[3]}; o4[2] = fc::cpx{t[4], t[5]}; o4[3] = fc::cpx{t[6], t[7]}; }
            else { const float tp = (q - L / 8 > 0) ? h2f(top[it - NG]) : 0.f; o4[0] = fc::cpx{tp, t[7]}; o4[1] = fc::cpx{t[6], t[5]}; o4[2] = fc::cpx{t[4], t[3]}; o4[3] = fc::cpx{t[2], t[1]}; }
#pragma unroll
            for (int i = 0; i < 4; ++i) { lds[fc::padi(4 * q) + i] = o4[i]; part += fabsf(o4[i].x) + fabsf(o4[i].y); } }
        part = wave_sum(part, F.lane);
        if (F.lane == 0) red[F.wave] = part;
        CONV_SYNC;
        float S = 0.f;
#pragma unroll
        for (int w = 0; w < 8 / NH; ++w) S += red[hh * 4 + w];
        FC_FWD(M, NT, lds, tl, CONV_SYNC);
        fc::filter_pass<M, NT>(lds, tl, 1.0f / (8.0f * (float)M * S), kb + o * KB_ORDER);
        CONV_SYNC_FULL;
    }
    const float* cw = F.inp(6) + (size_t)hj * 3 * NHY; const float* cbp = F.inp(7) + (size_t)hj * NHY; const float* sk = F.inp(16) + (size_t)hj * 2 * D;
    fc::f4* z1g = kb + 2 * KB_ORDER + hh * 2048;
#pragma unroll 1
    for (int s = 0; s < nseq; s += NH) {
        const int tok = tok0 + (s + hh) * L;
        const unsigned* uv = (const unsigned*)(UT + (size_t)c * NTOK + tok);
        const unsigned* ux1 = (const unsigned*)(UT + (size_t)(D + c) * NTOK + tok);
        const unsigned* ux2 = (const unsigned*)(UT + (size_t)(2 * D + c) * NTOK + tok);
        OPAQUE_V(tl);
        { SC_LOAD(cv, c);
          Raw8 rv[NG];
#pragma unroll
          for (int j = 0; j < NG; ++j) rv[j] = ld8(uv, tl + NT * j, L / 8);
#pragma unroll
          for (int j = 0; j < NG; ++j) { const int q = tl + NT * j; fc::cpx o4[4]; sconv8(rv[j], cv0, cv1, cv2, cvb, o4);
#pragma unroll
              for (int i = 0; i < 4; ++i) { lds[fc::padi(4 * q) + i] = o4[i]; } } }
        CONV_SYNC;
        { FC_FWD12Z(M, NT, lds, tl, CONV_SYNC);
          fc::KRegs<M, NT> kr; fc::k_prefetch<M, NT>(kb, tl, kr);
          FC_FWD3(M, NT, lds, tl, CONV_SYNC);
          fc::mult_pass<M, NT>(lds, tl, kr); }
        CONV_SYNC;
        OPAQUE_V(tl);
        { Raw8 rv[NG], ra[NG];
#pragma unroll
          for (int j = 0; j < NG; ++j) { rv[j] = ld8(uv, tl + NT * j, L / 8); ra[j] = ld8(ux1, tl + NT * j, L / 8); }
          FC_INVZ(M, NT, lds, tl, CONV_SYNC);
          SC_LOAD(cv, c); SC_LOAD(ca, D + c); const float skip0 = RFL(sk[c]);
#pragma unroll
          for (int j = 0; j < NG; ++j) { const int q = tl + NT * j; fc::cpx v4[4], a4[4], z[4]; sconv8(rv[j], cv0, cv1, cv2, cvb, v4); sconv8(ra[j], ca0, ca1, ca2, cab, a4);
#pragma unroll
              for (int i = 0; i < 4; ++i) { const fc::cpx y = lds[fc::padi(4 * q) + i]; z[i] = a4[i] * (y + skip0 * v4[i]); lds[fc::padi(4 * q) + i] = z[i]; }
              z1g[(j * NT + tl) * 2] = fc::f4{z[0].x, z[0].y, z[1].x, z[1].y}; z1g[(j * NT + tl) * 2 + 1] = fc::f4{z[2].x, z[2].y, z[3].x, z[3].y}; } }
        CONV_SYNC;
        { FC_FWD12Z(M, NT, lds, tl, CONV_SYNC);
          fc::KRegs<M, NT> kr; fc::k_prefetch<M, NT>(kb + KB_ORDER, tl, kr);
          FC_FWD3(M, NT, lds, tl, CONV_SYNC);
          fc::mult_pass<M, NT>(lds, tl, kr); }
        CONV_SYNC;
        OPAQUE_V(tl);
        { Raw8 rx[NG]; fc::f4 zp[NG][2];
#pragma unroll
          for (int j = 0; j < NG; ++j) { rx[j] = ld8(ux2, tl + NT * j, L / 8); zp[j][0] = z1g[(j * NT + tl) * 2]; zp[j][1] = z1g[(j * NT + tl) * 2 + 1]; }
          FC_INVZ(M, NT, lds, tl, CONV_SYNC);
          SC_LOAD(cx, 2 * D + c); const float skip1 = RFL(sk[D + c]);
          v4u* zo = (v4u*)(ZO + (size_t)c * NTOK + tok);
#pragma unroll
          for (int j = 0; j < NG; ++j) { const int q = tl + NT * j; fc::cpx x4[4]; sconv8(rx[j], cx0, cx1, cx2, cxb, x4);
              unsigned w[4];
#pragma unroll
              for (int i = 0; i < 4; ++i) { const fc::cpx y = lds[fc::padi(4 * q) + i]; const fc::cpx z1 = fc::cpx{zp[j][i >> 1][2 * (i & 1)], zp[j][i >> 1][2 * (i & 1) + 1]}; const fc::cpx z2 = x4[i] * (y + skip1 * z1); w[i] = pk2(z2.x, z2.y); }
              zo[q] = v4u{w[0], w[1], w[2], w[3]}; } }
        CONV_SYNC;
    }
}
__device__ __forceinline__ void conv_phase(const Frame& F, int hj, const unsigned short* HT, bf16* UT, bf16* ZO, fc::f4* KB) {
    fc::f4* kb = KB + (size_t)F.bx * KB_BLOCK;
    for (int c = F.bx; c < D; c += F.G) {
        conv_part<LP, 256>(F, hj, c, NBP, 0, 0, HT, UT, ZO, kb);
        conv_part<LS, 512>(F, hj, c, 1, NTOKP, LP, HT, UT, ZO, kb);
    }
}
__device__ __forceinline__ void transpose_phase(const Frame& F, const bf16* ZT, bf16* Z) {
    constexpr int PIT = 68;
    LAS bf16* t = (LAS bf16*)(F.lds + F.wave * (64 * PIT * 2));
    const int gw = F.vcu * NWAVES + F.wave, NGW = F.G * NWAVES, lane = F.lane;
    constexpr int TN = NTOK / 64, NTILE = (D / 64) * TN;
    v4u w[8];
    if (gw < NTILE) { const int cb = gw / TN, tb = gw % TN;
#pragma unroll
        for (int i = 0; i < 8; ++i) w[i] = *(const GAS v4u*)(ZT + (size_t)(64 * cb + 8 * i + (lane >> 3)) * NTOK + 64 * tb + 8 * (lane & 7)); }
    for (int it = gw; it < NTILE; it += NGW) {
        const int cb = it / TN, tb = it % TN, c0 = 64 * cb, t0 = 64 * tb;
#pragma unroll
        for (int i = 0; i < 8; ++i) { const int ch = 8 * i + (lane >> 3), t8 = lane & 7;
            LAS v2u* p = (LAS v2u*)(t + ch * PIT + 8 * t8); p[0] = v2u{w[i].x, w[i].y}; p[1] = v2u{w[i].z, w[i].w}; }
        { const int in = (it + NGW < NTILE) ? it + NGW : it, cbn = in / TN, tbn = in % TN;
#pragma unroll
          for (int i = 0; i < 8; ++i) w[i] = *(const GAS v4u*)(ZT + (size_t)(64 * cbn + 8 * i + (lane >> 3)) * NTOK + 64 * tbn + 8 * (lane & 7)); }
        LDS_WAIT(); asm volatile("" ::: "memory");
#pragma unroll
        for (int i = 0; i < 8; ++i) { const int tk = 8 * i + (lane >> 3), c8 = lane & 7;
            const LAS bf16* s = t + (8 * c8) * PIT + tk;
            v4u o; o.x = (unsigned)s[0] | ((unsigned)s[PIT] << 16); o.y = (unsigned)s[2 * PIT] | ((unsigned)s[3 * PIT] << 16);
            o.z = (unsigned)s[4 * PIT] | ((unsigned)s[5 * PIT] << 16); o.w = (unsigned)s[6 * PIT] | ((unsigned)s[7 * PIT] << 16);
            *(GAS v4u*)(Z + (size_t)(t0 + tk) * D + c0 + 8 * c8) = o; }
        LDS_WAIT(); asm volatile("" ::: "memory");
    }
}
constexpr int ATT_BW = 321;
constexpr int ATT_KPITCH = 272, ATT_VPITCH = 320, ATT_K_OFF = 0, ATT_V_OFF = 128 * ATT_KPITCH, ATT_B_OFF = ATT_V_OFF + 128 * ATT_VPITCH, ATT_QPITCH = 272, ATT_STAGE = 32 * ATT_QPITCH, ATT_UNITS = (NTOK / 128) * NKV * 2;
__device__ __forceinline__ int t5_bucket(int rel) {
    const int n = rel < 0 ? -rel : rel; int b;
    if (n < 8) b = n; else if (n < 12) b = 8; else if (n < 16) b = 9; else if (n < 23) b = 10; else if (n < 32) b = 11; else if (n < 46) b = 12; else if (n < 64) b = 13; else if (n < 91) b = 14; else b = 15;
    return b + (rel > 0 ? 16 : 0);
}
typedef short v4i16_t __attribute__((ext_vector_type(4)));
__device__ __forceinline__ void attn_phase(const Frame& F, int aj, const bf16* QKV, bf16* O, const int dry = 0) {
    const int tid = F.tid, lane = F.lane, wave = F.wave, r32 = lane & 31, hi = lane >> 5;
    LAS unsigned char* lds = F.lds;
    LAS float* btab = (LAS float*)(lds + ATT_B_OFF);
    const float* qg = F.inp(20) + aj * HD; const float* kg = F.inp(21) + aj * HD; const float* sink = F.inp(22) + aj * NHEAD; const float* relb = F.inp(24);
    constexpr float LOG2E = 1.4426950408889634f;
    const int per = (ATT_UNITS + F.G - 1) / F.G;
    const int c16 = tid & 15, srow = tid >> 4;
    LAS float* qkt = (LAS float*)(lds + ATT_B_OFF + NHEAD * ATT_BW * 4);
    if (tid < HD) qkt[tid] = qg[tid] * kg[tid] * (0.08838834764831845f * 1.4426950408889634f);
    const int vtr = (4 * hi + ((lane >> 2) & 3)) * ATT_VPITCH + (16 * ((lane >> 4) & 1) + 4 * (lane & 3)) * 2;
    for (int idx = tid; idx < NHEAD * ATT_BW; idx += 512) { const int hh = idx / ATT_BW, rel = idx % ATT_BW - 160; btab[idx] = (rel >= -128 && rel <= 128) ? relb[t5_bucket(rel) * NHEAD + hh] * LOG2E : -1e30f; }
    __syncthreads();
    LAS unsigned char* stg = lds + wave * ATT_STAGE;
    const int st_row = lane >> 4, st_c16 = lane & 15;
    auto first_src = [&](int uu) -> const bf16* {
        const int g_ = (uu >> 1) & 3, blk_ = uu >> 3; int tokS_, n_;
        if (blk_ < 256) { tokS_ = (blk_ >> 6) * LP; n_ = blk_ & 63; } else { tokS_ = NTOKP; n_ = blk_ - 256; }
        return QKV + (size_t)(tokS_ + (n_ + ((n_ == 0) ? 1 : 0) - 1) * 128 + srow) * NQKV + 2048 + g_ * HD + 8 * c16;
    };
    const int qo = 32 * ((0x12032130u >> (4 * wave)) & 3);
    auto q_src = [&](int uu) -> const bf16* {
        const int hp_ = uu & 1, g_ = (uu >> 1) & 3, blk_ = uu >> 3; int tokS_, n_;
        if (blk_ < 256) { tokS_ = (blk_ >> 6) * LP; n_ = blk_ & 63; } else { tokS_ = NTOKP; n_ = blk_ - 256; }
        return QKV + (size_t)(tokS_ + n_ * 128 + qo + st_row) * NQKV + (4 * g_ + 2 * hp_ + (wave >> 2)) * HD + 8 * st_c16;
    };
    v4u qv[8];
    if (F.vcu * per < ATT_UNITS) { const bf16* qsrc = q_src(F.vcu * per);
#pragma unroll
        for (int i = 0; i < 8; ++i) qv[i] = *(const GAS v4u*)(qsrc + (size_t)(4 * i) * NQKV); }
    v4u kr[4], vr[4];
    if (F.vcu * per < ATT_UNITS) { const bf16* src = first_src(F.vcu * per);
#pragma unroll
        for (int p = 0; p < 4; ++p) { kr[p] = *(const GAS v4u*)(src + (size_t)(32 * p) * NQKV); vr[p] = *(const GAS v4u*)(src + (size_t)(32 * p) * NQKV + 512); } }
#pragma unroll 1
    for (int ui = 0; ui < per; ++ui) {
        const int u = F.vcu * per + ui;
        if (u >= ATT_UNITS) break;
        const int hp = u & 1, g = (u >> 1) & 3, blk = u >> 3;
        int tokS, L, n;
        if (blk < 256) { tokS = (blk >> 6) * LP; L = LP; n = blk & 63; } else { tokS = NTOKP; L = LS; n = blk - 256; }
        const int head = 4 * g + 2 * hp + (wave >> 2);
        const int ck0 = (n == 0) ? 1 : 0, ck1 = (n == L / 128 - 1) ? 1 : 2;
        bf16x8 qf[8];
        {
#pragma unroll
            for (int i = 0; i < 8; ++i) *(LAS v4u*)(stg + (st_row + 4 * i) * ATT_QPITCH + 16 * st_c16) = qv[i];
            LDS_WAIT(); asm volatile("" ::: "memory");
            v4u raw[8]; float ss = 0.f;
#pragma unroll
            for (int d0 = 0; d0 < 8; ++d0) { raw[d0] = *(const LAS v4u*)(stg + r32 * ATT_QPITCH + 32 * d0 + 16 * hi);
#pragma unroll
                for (int e = 0; e < 4; ++e) { const float a = bf_lo(raw[d0][e]), b = bf_hi(raw[d0][e]); ss += a * a + b * b; } }
            ss = sum_halves(ss);
            const float sc = __builtin_amdgcn_rsqf(ss * (1.0f / HD) + EPS);
            int hq = hi; OPAQUE_V(hq);
#pragma unroll
            for (int d0 = 0; d0 < 8; ++d0) { const f32x4 g0 = *(const LAS f32x4*)(qkt + 16 * d0 + 8 * hq), g1 = *(const LAS f32x4*)(qkt + 16 * d0 + 8 * hq + 4);
                v4u w;
                w.x = pk2(bf_lo(raw[d0].x) * sc * g0.x, bf_hi(raw[d0].x) * sc * g0.y); w.y = pk2(bf_lo(raw[d0].y) * sc * g0.z, bf_hi(raw[d0].y) * sc * g0.w);
                w.z = pk2(bf_lo(raw[d0].z) * sc * g1.x, bf_hi(raw[d0].z) * sc * g1.y); w.w = pk2(bf_lo(raw[d0].w) * sc * g1.z, bf_hi(raw[d0].w) * sc * g1.w);
                qf[d0] = __builtin_bit_cast(bf16x8, w); }
        }
        float mrun = sink[head] * LOG2E, lrun = (hi == 0) ? 1.0f : 0.0f;
        f32x16 negm;
#pragma unroll
        for (int e = 0; e < 16; ++e) negm[e] = -mrun;
        f32x16 oacc[4];
#pragma unroll
        for (int dt = 0; dt < 4; ++dt)
#pragma unroll
            for (int e = 0; e < 16; ++e) oacc[dt][e] = 0.f;
#pragma unroll 1
        for (int ck = ck0; ck <= (dry >= 3 ? ck0 - 1 : ck1); ++ck) {
            __syncthreads();
#pragma unroll
            for (int p = 0; p < 4; ++p) { const int row = srow + 32 * p;
                float ss = 0.f;
#pragma unroll
                for (int e = 0; e < 4; ++e) { const float a = bf_lo(kr[p][e]), b = bf_hi(kr[p][e]); ss += a * a + b * b; }
                ss = sum16(ss);
                const float rs = __builtin_amdgcn_rsqf(ss * (1.0f / HD) + EPS);
                v4u w;
                w.x = pk2(bf_lo(kr[p].x) * rs, bf_hi(kr[p].x) * rs); w.y = pk2(bf_lo(kr[p].y) * rs, bf_hi(kr[p].y) * rs);
                w.z = pk2(bf_lo(kr[p].z) * rs, bf_hi(kr[p].z) * rs); w.w = pk2(bf_lo(kr[p].w) * rs, bf_hi(kr[p].w) * rs);
                *(LAS v4u*)(lds + ATT_K_OFF + row * ATT_KPITCH + 16 * c16) = w;
                *(LAS v4u*)(lds + ATT_V_OFF + row * ATT_VPITCH + 16 * c16) = vr[p]; }
            __syncthreads();
            if (ck < ck1 || (ui + 1 < per && u + 1 < ATT_UNITS)) {
                const bf16* src = (ck < ck1) ? QKV + (size_t)(tokS + (n + ck) * 128 + srow) * NQKV + 2048 + g * HD + 8 * c16 : first_src(u + 1);
#pragma unroll
                for (int p = 0; p < 4; ++p) { kr[p] = *(const GAS v4u*)(src + (size_t)(32 * p) * NQKV); vr[p] = *(const GAS v4u*)(src + (size_t)(32 * p) * NQKV + 512); } }
#pragma unroll 1
            for (int kt = 0; kt < (dry >= 2 ? 0 : 4); ++kt) {
                const int T = 4 * ck + kt;
                if (T < (qo >> 5) || T > (qo >> 5) + 8) continue;
                const int relb0 = 32 * T + 4 * hi - 128 - (qo + r32);
                const LAS float* bt = btab + head * ATT_BW + 160;
                f32x16 sacc, sacc2;
                { unsigned bpa = (unsigned)(unsigned long long)(bt + relb0); OPAQUE_V(bpa); const LAS float* bp = (const LAS float*)(unsigned long long)bpa;
#pragma unroll
                  for (int e = 0; e < 16; ++e) sacc[e] = bp[(e & 3) + 8 * (e >> 2)]; }
                const LAS unsigned char* kp = lds + ATT_K_OFF + (32 * kt + r32) * ATT_KPITCH + 16 * hi;
                bf16x8 kfr[8];
                asm volatile("ds_read_b128 %0, %8\n\tds_read_b128 %1, %8 offset:32\n\tds_read_b128 %2, %8 offset:64\n\tds_read_b128 %3, %8 offset:96\n\t"
                             "ds_read_b128 %4, %8 offset:128\n\tds_read_b128 %5, %8 offset:160\n\tds_read_b128 %6, %8 offset:192\n\tds_read_b128 %7, %8 offset:224"
                             : "=&v"(kfr[0]), "=&v"(kfr[1]), "=&v"(kfr[2]), "=&v"(kfr[3]), "=&v"(kfr[4]), "=&v"(kfr[5]), "=&v"(kfr[6]), "=&v"(kfr[7]) : "v"(kp) : "memory");
                asm volatile("s_waitcnt lgkmcnt(0)" : "+v"(kfr[0]), "+v"(kfr[1]), "+v"(kfr[2]), "+v"(kfr[3]), "+v"(kfr[4]), "+v"(kfr[5]), "+v"(kfr[6]), "+v"(kfr[7]));
#pragma unroll
                for (int d0 = 0; d0 < 8; d0 += 2) { sacc2 = __builtin_amdgcn_mfma_f32_32x32x16_bf16(kfr[d0 + 1], qf[d0 + 1], d0 == 0 ? negm : sacc2, 0, 0, 0); sacc = __builtin_amdgcn_mfma_f32_32x32x16_bf16(kfr[d0], qf[d0], sacc, 0, 0, 0); }
#pragma unroll
                for (int e = 0; e < 16; ++e) sacc[e] += sacc2[e];
                float mx = -1e30f;
#pragma unroll
                for (int e = 0; e < 16; ++e) mx = fmaxf(mx, sacc[e]);
                mx = max_halves(mx);
                if (__builtin_amdgcn_ballot_w64(mx > 8.0f) != 0ull) {
                    const float dm = fmaxf(mx, 0.f), alpha = __builtin_amdgcn_exp2f(-dm);
                    mrun += dm; lrun *= alpha;
#pragma unroll
                    for (int e = 0; e < 16; ++e) { sacc[e] -= dm; negm[e] = -mrun; }
#pragma unroll
                    for (int dt = 0; dt < 4; ++dt)
#pragma unroll
                        for (int e = 0; e < 16; ++e) oacc[dt][e] *= alpha; }
                float ps = 0.f;
#pragma unroll
                for (int e = 0; e < 16; ++e) { const float p = __builtin_amdgcn_exp2f(sacc[e]); sacc[e] = p; ps += p; }
                lrun += ps;
                bf16x8 pf[2];
#pragma unroll
                for (int s = 0; s < 2; ++s) { v4u w; w.x = pk2(sacc[8 * s + 0], sacc[8 * s + 1]); w.y = pk2(sacc[8 * s + 2], sacc[8 * s + 3]); w.z = pk2(sacc[8 * s + 4], sacc[8 * s + 5]); w.w = pk2(sacc[8 * s + 6], sacc[8 * s + 7]);
                    pf[s] = __builtin_bit_cast(bf16x8, w); }
#pragma unroll
                for (int s = 0; s < 2; ++s)
                { v4i16_t a0[4], a1[4];
#pragma unroll
                    for (int dt = 0; dt < 4; ++dt) { const LAS unsigned char* vp = lds + ATT_V_OFF + (32 * kt) * ATT_VPITCH + 64 * dt + vtr;
                        a0[dt] = __builtin_amdgcn_ds_read_tr16_b64_v4i16((LAS v4i16_t*)(vp + (16 * s) * ATT_VPITCH));
                        a1[dt] = __builtin_amdgcn_ds_read_tr16_b64_v4i16((LAS v4i16_t*)(vp + (16 * s + 8) * ATT_VPITCH)); }
#pragma unroll
                    for (int dt = 0; dt < 4; ++dt) { const bf16x8 af = (bf16x8){a0[dt][0], a0[dt][1], a0[dt][2], a0[dt][3], a1[dt][0], a1[dt][1], a1[dt][2], a1[dt][3]};
                        oacc[dt] = __builtin_amdgcn_mfma_f32_32x32x16_bf16(af, pf[s], oacc[dt], 0, 0, 0); } }
            }
        }
        const float ltot = sum_halves(lrun), inv = __builtin_amdgcn_rcpf(ltot);
        { const bf16* qsrc = q_src((ui + 1 < per && u + 1 < ATT_UNITS) ? u + 1 : u);
#pragma unroll
            for (int i = 0; i < 8; ++i) qv[i] = *(const GAS v4u*)(qsrc + (size_t)(4 * i) * NQKV); }
        __syncthreads();
#pragma unroll
        for (int dt = 0; dt < 4; ++dt)
#pragma unroll
            for (int q4 = 0; q4 < 4; ++q4) { v2u w; w.x = pk2(oacc[dt][4 * q4] * inv, oacc[dt][4 * q4 + 1] * inv); w.y = pk2(oacc[dt][4 * q4 + 2] * inv, oacc[dt][4 * q4 + 3] * inv);
                *(LAS v2u*)(stg + r32 * ATT_QPITCH + (32 * dt + 8 * q4 + 4 * hi) * 2) = w; }
        LDS_WAIT(); asm volatile("" ::: "memory");
        { bf16* odst = O + (size_t)(tokS + n * 128 + qo + st_row) * D + head * HD + 8 * st_c16;
#pragma unroll
          for (int i = 0; i < 8; ++i) { const v4u w = *(const LAS v4u*)(stg + (st_row + 4 * i) * ATT_QPITCH + 16 * st_c16); *(GAS v4u*)(odst + (size_t)(4 * i) * D) = w; } }
    }
}

__global__ void __launch_bounds__(NWAVES * 64, 2) trunk_fwd(Args args) {
    extern __shared__ __attribute__((aligned(16))) unsigned char lds_raw[];
    Frame F;
    F.lds = (LAS unsigned char*)lds_raw;
    F.tid = threadIdx.x; F.lane = F.tid & 63; F.wave = __builtin_amdgcn_readfirstlane(F.tid >> 6);
    F.G = gridDim.x; F.bx = blockIdx.x; { const int bx = blockIdx.x; F.vcu = (F.G % 8 == 0) ? (bx % 8) * (F.G / 8) + bx / 8 : bx; }
    volatile LAS unsigned* MISC = (volatile LAS unsigned*)(F.lds + MISC_OFF);
    if (F.tid < 64) MISC[F.tid] = 0u;
    __syncthreads();
    if (F.tid < 27) { const unsigned long long v = (unsigned long long)args.in[F.tid]; MISC[64 + 2 * F.tid] = (unsigned)v; MISC[65 + 2 * F.tid] = (unsigned)(v >> 32); }
    if (F.tid == 27) { const unsigned long long v = (unsigned long long)args.out; MISC[64 + 54] = (unsigned)v; MISC[64 + 55] = (unsigned)(v >> 32); }
    if (F.tid == 28) { const unsigned long long v = (unsigned long long)args.ws; MISC[64 + 56] = (unsigned)v; MISC[64 + 57] = (unsigned)(v >> 32); }
    __syncthreads();
    XcdBarrier bar; bar.bar = (unsigned*)(args.ws + WS_CTL) + CW_BAR; bar.x = 0; bar.st = nullptr;
    if (!MK_PER_PHASE) bar = xcd_barrier_post((unsigned*)(args.ws + WS_CTL) + CW_BAR, MISC + 8);
    const int lo = args.ph_lo, hi = args.ph_hi;
#if defined(PROBE_REP) || defined(PROBE_ATT) || defined(PROBE_UB)
    const int dry = args.dry;
#else
    constexpr int dry = 0;
#endif
#define IN(k) (lo <= (k) && (k) < hi)
#define SEAM(k) do { if (IN(k) && IN((k) + 1)) xcd_barrier(bar); } while (0)
#define WSB(off) ((bf16*)(Fp.wsp() + (off)))

#define RSS(n) ((float*)(Fp.wsp() + WS_RSS) + (size_t)((n) & 1) * NTOK * 8)
#define EPART ((pg8_las_f*)(Fp.lds + 131072))
#define ETAB ((pg8_las_f*)(Fp.lds + 131072 + 4096))
#define ERAW ((pg8_las_f*)(Fp.lds + 131072 + 5120))
#ifdef PROBE_UB
    if (IN(0) && dry >= 2) { PH_FRAME(Fp);
        typedef float f2 __attribute__((ext_vector_type(2)));
        f2 acc[16]; float s = (float)Fp.tid * 1e-9f;
#pragma unroll
        for (int i = 0; i < 16; ++i) acc[i] = (f2){s + i, s - i};
        const f2 m = (f2){0.999f, 0.998f}, ad = (f2){1e-3f, 2e-3f};
#pragma unroll 1
        for (int it = 0; it < 16384; ++it) {
#pragma unroll
            for (int i = 0; i < 16; ++i) {
                if (dry == 2) asm volatile("v_pk_fma_f32 %0, %0, %1, %2" : "+v"(acc[i]) : "v"(m), "v"(ad));
                else if (dry == 3) asm volatile("v_fma_f32 %0, %0, %1, %2" : "+v"(acc[i].x) : "v"(m.x), "v"(ad.x));
                else asm volatile("v_pk_add_f32 %0, %0, %1" : "+v"(acc[i]) : "v"(ad));
            }
        }
        float t = 0.f;
#pragma unroll
        for (int i = 0; i < 16; ++i) t += acc[i].x + acc[i].y;
        if (t != t) ((float*)WSB(WS_KB))[Fp.tid] = t;
    } else
#endif
    if (IN(0)) { PH_FRAME(Fp);
        filter_mlp(Fp, WSB(WS_A3X), WSB(WS_WOX));
        cvt_weight<0>(Fp, Fp.inp(4), Fp.inp(2), D, NHY, WSB(WS_WMA));
        cvt_weight<0>(Fp, Fp.inp(17), nullptr, D, D, WSB(WS_WMB));
        prep_rows(Fp, Fp.inp(0), Fp.inp(1), WSB(WS_XN), RSS(0));
    }
    SEAM(0);
#pragma unroll 1
    for (int p = 0; p < 2; ++p) {
        const int base = 1 + 11 * p;
        {
            const int layer = 2 * p;
            if (IN(base + 0)) { PH_FRAME(Fp);
                { pg8::Gemm g{WSB(WS_WMA), WSB(WS_XN), NHY, NTOK, D}; pg8::StaticOrder S; S.init(NHY, NTOK, Fp.G, Fp.bx);
                  pg8::EpiBf16 E{WSB(WS_BIG), NTOK, Fp.inp(5) + (size_t)p * NHY, nullptr, RSS(2 * layer), ETAB, ERAW};
                  pg8::gemm_phase<pg8::EpiBf16, pg8::StaticOrder, true, true>(Fp.lds, g, S, E, Fp.wave); }
                { int kt = 256; OPAQUE_S(kt);
                  pg8::Gemm g{WSB(WS_WOX) + (size_t)p * HT_ROWS * 256, WSB(WS_A3X) + (size_t)p * HT_COLS * 256, HT_ROWS, HT_COLS, kt}; pg8::StaticOrder S; S.init(HT_ROWS, HT_COLS, Fp.G, Fp.bx);
                  pg8::EpiTaps E{(unsigned short*)WSB(WS_HT), HT_COLS};
                  pg8::gemm_phase<pg8::EpiTaps, pg8::StaticOrder, true, true>(Fp.lds, g, S, E, Fp.wave); }
            }
            SEAM(base + 0);
            if (IN(base + 1)) { PH_FRAME(Fp);
                cvt_weight<1>(Fp, Fp.inp(25) + (size_t)layer * D * NGU, Fp.inp(3) + layer * D, D, NGU, WSB(WS_WGU));
                cvt_weight<0>(Fp, Fp.inp(26) + (size_t)layer * DFF * D, nullptr, DFF, D, WSB(WS_WDN));
                __syncthreads();
                conv_phase(Fp, p, (unsigned short*)WSB(WS_HT), WSB(WS_BIG), dry ? WSB(WS_XN) : WSB(WS_BIG), (fc::f4*)WSB(WS_KB));
            }
            SEAM(base + 1);
            if (IN(base + 2)) { PH_FRAME(Fp); transpose_phase(Fp, WSB(WS_BIG), WSB(WS_HT)); }
            SEAM(base + 2);
            if (IN(base + 3)) { PH_FRAME(Fp);
                pg8::Gemm g{WSB(WS_HT), WSB(WS_WMB), NTOK, D, D}; pg8::StaticOrder S; S.init(NTOK, D, Fp.G, Fp.bx);
                pg8::EpiRes16 E{WSB(WS_XN), D, Fp.inp(18) + (size_t)p * D, nullptr, RSS(2 * layer + 1), EPART};
                pg8::gemm_phase<pg8::EpiRes16, pg8::StaticOrder, true, true>(Fp.lds, g, S, E, Fp.wave);
            }
            SEAM(base + 3);
            if (IN(base + 4)) { PH_FRAME(Fp);
                cvt_weight<0>(Fp, Fp.inp(19) + (size_t)p * D * NQKV, Fp.inp(2) + (layer + 1) * D, D, NQKV, WSB(WS_WMA));
                cvt_weight<0>(Fp, Fp.inp(23) + (size_t)p * D * D, nullptr, D, D, WSB(WS_WMB));
                __syncthreads();
                pg8::Gemm g{WSB(WS_XN), WSB(WS_WGU), NTOK, NGU, D}; pg8::StaticOrder S; S.init(NTOK, NGU, Fp.G, Fp.bx);
                pg8::EpiSwiGLU E{WSB(WS_BIG), DFF, RSS(2 * layer + 1), ETAB, ERAW};
                pg8::gemm_phase<pg8::EpiSwiGLU, pg8::StaticOrder, true, true>(Fp.lds, g, S, E, Fp.wave);
            }
            SEAM(base + 4);
            if (IN(base + 5)) { PH_FRAME(Fp);
                pg8::Gemm g{WSB(WS_BIG), WSB(WS_WDN), NTOK, D, DFF}; pg8::StaticOrder S; S.init(NTOK, D, Fp.G, Fp.bx);
                pg8::EpiRes16 E{WSB(WS_XN), D, nullptr, nullptr, RSS(2 * layer + 2), EPART};
                pg8::gemm_phase<pg8::EpiRes16, pg8::StaticOrder, true, true>(Fp.lds, g, S, E, Fp.wave);
            }
            SEAM(base + 5);
        }
        {
            const int layer = 2 * p + 1;
            if (IN(base + 6)) { PH_FRAME(Fp);
                pg8::Gemm g{WSB(WS_XN), WSB(WS_WMA), NTOK, NQKV, D}; pg8::StaticOrder S; S.init(NTOK, NQKV, Fp.G, Fp.bx);
                pg8::EpiBf16 E{WSB(WS_BIG), NQKV, nullptr, RSS(2 * layer), nullptr, ETAB, ERAW};
                pg8::gemm_phase<pg8::EpiBf16, pg8::StaticOrder, true, true>(Fp.lds, g, S, E, Fp.wave);
            }
            SEAM(base + 6);
            if (IN(base + 7)) { PH_FRAME(Fp);
                cvt_weight<1>(Fp, Fp.inp(25) + (size_t)layer * D * NGU, Fp.inp(3) + layer * D, D, NGU, WSB(WS_WGU));
                cvt_weight<0>(Fp, Fp.inp(26) + (size_t)layer * DFF * D, nullptr, DFF, D, WSB(WS_WDN));
                __syncthreads();
                attn_phase(Fp, p, WSB(WS_BIG), WSB(WS_HT), dry);
            }
            SEAM(base + 7);
            if (IN(base + 8)) { PH_FRAME(Fp);
                pg8::Gemm g{WSB(WS_HT), WSB(WS_WMB), NTOK, D, D}; pg8::StaticOrder S; S.init(NTOK, D, Fp.G, Fp.bx);
                pg8::EpiRes16 E{WSB(WS_XN), D, nullptr, nullptr, RSS(2 * layer + 1), EPART};
                pg8::gemm_phase<pg8::EpiRes16, pg8::StaticOrder, true, true>(Fp.lds, g, S, E, Fp.wave);
            }
            SEAM(base + 8);
            if (IN(base + 9)) { PH_FRAME(Fp);
                if (p == 0) { cvt_weight<0>(Fp, Fp.inp(4) + (size_t)D * NHY, Fp.inp(2) + (layer + 1) * D, D, NHY, WSB(WS_WMA));
                              cvt_weight<0>(Fp, Fp.inp(17) + (size_t)D * D, nullptr, D, D, WSB(WS_WMB)); }
                __syncthreads();
                pg8::Gemm g{WSB(WS_XN), WSB(WS_WGU), NTOK, NGU, D}; pg8::StaticOrder S; S.init(NTOK, NGU, Fp.G, Fp.bx);
                pg8::EpiSwiGLU E{WSB(WS_BIG), DFF, RSS(2 * layer + 1), ETAB, ERAW};
                pg8::gemm_phase<pg8::EpiSwiGLU, pg8::StaticOrder, true, true>(Fp.lds, g, S, E, Fp.wave);
            }
            SEAM(base + 9);
            if (IN(base + 10)) { PH_FRAME(Fp);
                pg8::Gemm g{WSB(WS_BIG), WSB(WS_WDN), NTOK, D, DFF}; pg8::StaticOrder S; S.init(NTOK, D, Fp.G, Fp.bx);
                pg8::EpiRes16 E{WSB(WS_XN), D, nullptr, p == 0 ? (float*)nullptr : Fp.outp(), p == 0 ? RSS(2 * layer + 2) : (float*)nullptr, EPART};
                pg8::gemm_phase<pg8::EpiRes16, pg8::StaticOrder, true, true>(Fp.lds, g, S, E, Fp.wave);
            }
            SEAM(base + 10);
        }
    }
#undef RSS
#undef EPART
#undef ETAB
#undef ERAW
#undef IN
#undef SEAM
#undef WSB
}

extern "C" void kernel_launch(void* const* d_in, const int* in_sizes, int n_in, void* d_out, int out_size, void* d_ws, size_t ws_size, hipStream_t stream) {
    static int grid = 0;
    if (grid == 0) {
        if (n_in != 27 || out_size != NTOK * D || ws_size < WS_END) { fprintf(stderr, "kernel_launch: unexpected shapes: n_in %d out %d ws %zu (need %zu)\n", n_in, out_size, ws_size, (size_t)WS_END); grid = -1; return; }
        int dev = 0, cus = 0, per_cu = 0;
        if (hipGetDevice(&dev) != hipSuccess || hipDeviceGetAttribute(&cus, hipDeviceAttributeMultiprocessorCount, dev) != hipSuccess) { grid = -1; return; }
        if (hipFuncSetAttribute((const void*)trunk_fwd, hipFuncAttributeMaxDynamicSharedMemorySize, LDS_BYTES) != hipSuccess) { fprintf(stderr, "kernel_launch: hipFuncSetAttribute failed\n"); grid = -1; return; }
        if (hipOccupancyMaxActiveBlocksPerMultiprocessor(&per_cu, (const void*)trunk_fwd, NWAVES * 64, LDS_BYTES) != hipSuccess || per_cu < 1) fprintf(stderr, "kernel_launch: occupancy query reports %d\n", per_cu);
        (void)hipGetLastError();
        grid = cus;
        if (grid != 256) fprintf(stderr, "kernel_launch: %d CUs (built for 256)\n", grid);
    }
    if (grid < 0) return;
    if (hipMemsetAsync((char*)d_ws + WS_CTL, 0, CTL_ZERO_BYTES, stream) != hipSuccess) return;
    Args a{};
    for (int i = 0; i < 27; ++i) a.in[i] = (const float*)d_in[i];
    a.out = (float*)d_out; a.ws = (unsigned char*)d_ws;
#if MK_PER_PHASE
    for (int ph = 0; ph < NPHASE; ++ph) {
        a.ph_lo = ph; a.ph_hi = ph + 1;
#ifdef PROBE_REP
        { const int kk = ph == 0 ? -1 : (ph - 1) % 11;
          const int cls = (ph == 0 || kk == 2) ? 64 : (kk == 0 || kk == 6) ? 1 : (kk == 1) ? 2 : (kk == 7) ? 4 : (kk == 4 || kk == 9) ? 8 : (kk == 3 || kk == 8) ? 16 : 32;
#ifdef PROBE_ATT
          if (kk == 7) { a.dry = PROBE_ATT; hipLaunchKernelGGL(trunk_fwd, dim3(grid), dim3(NWAVES * 64), LDS_BYTES, stream, a); a.dry = 0; }
#endif
#ifdef PROBE_UB
          if (ph == 0) { a.dry = PROBE_UB; hipLaunchKernelGGL(trunk_fwd, dim3(grid), dim3(NWAVES * 64), LDS_BYTES, stream, a); a.dry = 0; }
#endif
          if (PROBE_REP & cls) { a.dry = 1; hipLaunchKernelGGL(trunk_fwd, dim3(grid), dim3(NWAVES * 64), LDS_BYTES, stream, a); a.dry = 0; } }
#endif
        hipLaunchKernelGGL(trunk_fwd, dim3(grid), dim3(NWAVES * 64), LDS_BYTES, stream, a);
    }
#else
    a.ph_lo = 0; a.ph_hi = NPHASE;
    hipLaunchKernelGGL(trunk_fwd, dim3(grid), dim3(NWAVES * 64), LDS_BYTES, stream, a);
#endif
    const hipError_t le = hipPeekAtLastError();
    if (le != hipSuccess) fprintf(stderr, "kernel_launch: launch failed: %s\n", hipGetErrorName(le));
}
```

```cpp
#include <hip/hip_runtime.h>
#include <cstdio>
#include <cstdint>
#define FC_ASM_CMUL
#define FC_ASM_CMULK
namespace pg8 {
#define PG8_LAS __attribute__((address_space(3)))
typedef unsigned short bf16_t;
typedef short bf16x8 __attribute__((ext_vector_type(8)));
typedef float f32x4 __attribute__((ext_vector_type(4)));
typedef unsigned u32x4 __attribute__((ext_vector_type(4)));
constexpr int BM = 256, BK = 64, HALF = 128, HTB = HALF * BK * 2  , STAGE_BYTES = 8 * HTB, NXCD = 8, WGM = 4;

__host__ __device__ __forceinline__ int lds_byte(int r, int c) { const int st = (r >> 4) * 2 + (c >> 5), rr = r & 15, cc = c & 31, ob = rr * 64 + cc * 2; return st * 1024 + (ob ^ (((ob >> 9) & 1) << 5)); }
__host__ __device__ __forceinline__ void stage_rc(int b, int& R, int& C) { const int st = b / 1024, sb = b % 1024, swz = sb ^ (((sb >> 9) & 1) << 5); R = (st >> 1) * 16 + swz / 64; C = (st & 1) * 32 + (swz % 64) / 2; }
__host__ __device__ __forceinline__ int perm32(int rho) { const int n = rho >> 4, i = rho & 15; return 8 * (i >> 2) + 4 * n + (i & 3); }

struct Unit { int pm, pn; };
struct Gemm { const bf16_t* A; const bf16_t* Bt; int M, N, K; };

struct StaticOrder {
    int nM, nN, nwg, G, c;
    __host__ __device__ void init(int M, int N, int G_, int c_) { nM = M / BM; nN = N / BM; nwg = nM * nN; G = G_; c = c_; }
    __host__ __device__ bool next(int i, Unit& u) const {
        const long L = (long)i * G + c; if (L >= nwg) return false;
        int wgid = (int)L; { const int q = nwg / NXCD, r = nwg % NXCD, xcd = wgid % NXCD, off = wgid / NXCD; wgid = (xcd < r ? xcd * (q + 1) : r * (q + 1) + (xcd - r) * q) + off; }
        const int nig = WGM * nN, gid = wgid / nig, fm = gid * WGM, gsz = (nM - fm) < WGM ? (nM - fm) : WGM;
        u.pm = fm + ((wgid % nig) % gsz); u.pn = (wgid % nig) / gsz; return true;
    }
    __device__ __forceinline__ void a_ready(const Unit&) const {}
    __device__ __forceinline__ void done(const Unit&) const {}
};

__device__ __forceinline__ unsigned cvt_pk_bf16(float lo, float hi) { unsigned r; asm volatile("v_cvt_pk_bf16_f32 %0, %1, %2" : "=v"(r) : "v"(lo), "v"(hi)); return r; }
typedef float f32x2 __attribute__((ext_vector_type(2)));
__device__ __forceinline__ unsigned cvt_pk_f16(float lo, float hi) { typedef _Float16 h2_t __attribute__((ext_vector_type(2))); h2_t v; v.x = (_Float16)lo; v.y = (_Float16)hi; return __builtin_bit_cast(unsigned, v); }
__device__ __forceinline__ float rstd_of(float ss) { return __builtin_amdgcn_rsqf(ss * (1.0f / 2048.0f) + 1e-6f); }
__device__ __forceinline__ float rstd8(const float* rss, int t) { const f32x4 a = *(const f32x4*)(rss + (size_t)t * 8), b = *(const f32x4*)(rss + (size_t)t * 8 + 4); return rstd_of(((a[0] + a[1]) + (a[2] + a[3])) + ((b[0] + b[1]) + (b[2] + b[3]))); }
__device__ __forceinline__ void rss_prefetch(PG8_LAS float* raw, const float* rss, int tok0, int wid, int lane) {
    __builtin_amdgcn_global_load_lds((const unsigned*)(rss + (size_t)tok0 * 8 + (wid * 64 + lane) * 4), (PG8_LAS unsigned*)(raw + wid * 256), 16, 0, 0);
}
__device__ __forceinline__ void rstd_table(PG8_LAS float* tab, PG8_LAS const float* raw, int wr, int wc, int fr, int fq) {
    if (wr == 0) { const int r = wc * 64 + fr + 16 * fq; const f32x4 a = *(PG8_LAS const f32x4*)(raw + r * 8), b = *(PG8_LAS const f32x4*)(raw + r * 8 + 4);
        tab[r] = rstd_of(((a[0] + a[1]) + (a[2] + a[3])) + ((b[0] + b[1]) + (b[2] + b[3]))); }
    asm volatile("s_waitcnt lgkmcnt(0)" ::: "memory"); __builtin_amdgcn_s_barrier(); asm volatile("" ::: "memory");
}
struct EpiBf16 {
    static constexpr bool PERM = true, AFTER_DRAIN = false;
    bf16_t* O; int ldc; const float* rbias; const float* rss_row; const float* rss_col; PG8_LAS float* tab; PG8_LAS float* raw;
    __device__ __forceinline__ void prefetch(const Unit& u, int wid, int lane) const { if (rss_col) rss_prefetch(raw, rss_col, u.pn * BM, wid, lane); else if (rss_row) rss_prefetch(raw, rss_row, u.pm * BM, wid, lane); }
    __device__ __forceinline__ void operator()(const f32x4 (&acc)[2][2][4][2], const Unit& u, int wr, int wc, int fr, int fq) const {
        const int row0 = u.pm * BM + wr * 64 + fr, col0 = u.pn * BM + wc * 32 + 8 * fq;
        f32x4 cs[2][2];
#pragma unroll
        for (int bj = 0; bj < 2; ++bj)
#pragma unroll
            for (int n = 0; n < 2; ++n) cs[bj][n] = (f32x4){1.f, 1.f, 1.f, 1.f};
        if (rss_col) { rstd_table(tab, raw, wr, wc, fr, fq);
#pragma unroll
            for (int bj = 0; bj < 2; ++bj)
#pragma unroll
                for (int n = 0; n < 2; ++n) cs[bj][n] = *(const PG8_LAS f32x4*)(tab + bj * HALF + wc * 32 + 8 * fq + 4 * n); }
        if (rss_row) rstd_table(tab, raw, wr, wc, fr, fq);
#pragma unroll
        for (int ai = 0; ai < 2; ++ai)
#pragma unroll
            for (int m = 0; m < 4; ++m) { const int row = row0 + ai * HALF + m * 16; bf16_t* rowp = O + (size_t)row * ldc + col0; const float b = rbias ? rbias[row] : 0.f;
                const float rs = rss_row ? tab[ai * HALF + wr * 64 + m * 16 + fr] : 1.f;
#pragma unroll
                for (int bj = 0; bj < 2; ++bj) { const f32x4 v0 = acc[ai][bj][m][0] * cs[bj][0] * rs + b, v1 = acc[ai][bj][m][1] * cs[bj][1] * rs + b;
                    u32x4 w; w.x = cvt_pk_bf16(v0[0], v0[1]); w.y = cvt_pk_bf16(v0[2], v0[3]); w.z = cvt_pk_bf16(v1[0], v1[1]); w.w = cvt_pk_bf16(v1[2], v1[3]);
                    __builtin_nontemporal_store(w, (u32x4*)(rowp + bj * HALF)); } }
    }
};
struct EpiSwiGLU {
    static constexpr bool PERM = true, AFTER_DRAIN = false;
    bf16_t* O; int ldc; const float* rss_row; PG8_LAS float* tab; PG8_LAS float* raw;
    __device__ __forceinline__ void prefetch(const Unit& u, int wid, int lane) const { rss_prefetch(raw, rss_row, u.pm * BM, wid, lane); }
    static __device__ __forceinline__ f32x4 sw4(f32x4 g, f32x4 u, float c1, float rs2) {
        const f32x4 t = g * c1;
        f32x4 e; e[0] = __builtin_amdgcn_exp2f(t[0]); e[1] = __builtin_amdgcn_exp2f(t[1]); e[2] = __builtin_amdgcn_exp2f(t[2]); e[3] = __builtin_amdgcn_exp2f(t[3]);
        const f32x4 d = e + 1.0f;
        f32x4 r; r[0] = __builtin_amdgcn_rcpf(d[0]); r[1] = __builtin_amdgcn_rcpf(d[1]); r[2] = __builtin_amdgcn_rcpf(d[2]); r[3] = __builtin_amdgcn_rcpf(d[3]);
        return ((g * u) * rs2) * r;
    }
    __device__ __forceinline__ void operator()(const f32x4 (&acc)[2][2][4][2], const Unit& u, int wr, int wc, int fr, int fq) const {
        const int row0 = u.pm * BM + wr * 64 + fr, col0 = u.pn * HALF + wc * 32 + 8 * fq;
        rstd_table(tab, raw, wr, wc, fr, fq);
#pragma unroll
        for (int ai = 0; ai < 2; ++ai)
#pragma unroll
            for (int m = 0; m < 4; ++m) { const int row = row0 + ai * HALF + m * 16; bf16_t* rowp = O + (size_t)row * ldc + col0;
                const float rs = tab[ai * HALF + wr * 64 + m * 16 + fr], c1 = -1.4426950408889634f * rs, rs2 = rs * rs;
                const f32x4 h0 = sw4(acc[ai][0][m][0], acc[ai][1][m][0], c1, rs2), h1 = sw4(acc[ai][0][m][1], acc[ai][1][m][1], c1, rs2);
                u32x4 w; w.x = cvt_pk_bf16(h0[0], h0[1]); w.y = cvt_pk_bf16(h0[2], h0[3]); w.z = cvt_pk_bf16(h1[0], h1[1]); w.w = cvt_pk_bf16(h1[2], h1[3]);
                __builtin_nontemporal_store(w, (u32x4*)rowp); }
    }
};
struct EpiRes16 {
    static constexpr bool PERM = true, AFTER_DRAIN = false;
    bf16_t* XN; int ldc; const float* bias; float* OUT; float* rss; PG8_LAS float* part;
    __device__ __forceinline__ void prefetch(const Unit&, int, int) const {}
    __device__ __forceinline__ void operator()(const f32x4 (&acc)[2][2][4][2], const Unit& u, int wr, int wc, int fr, int fq) const {
        const int row0 = u.pm * BM + wr * 64 + fr, col0 = u.pn * BM + wc * 32 + 8 * fq;
        f32x4 bv[2][2];
#pragma unroll
        for (int bj = 0; bj < 2; ++bj)
#pragma unroll
            for (int n = 0; n < 2; ++n) bv[bj][n] = bias ? *(const f32x4*)(bias + col0 + bj * HALF + 4 * n) : (f32x4){0.f, 0.f, 0.f, 0.f};
        u32x4 xin[4][2];
#pragma unroll
        for (int m = 0; m < 4; ++m)
#pragma unroll
            for (int bj = 0; bj < 2; ++bj) xin[m][bj] = *(const u32x4*)(XN + (size_t)(row0 + m * 16) * ldc + col0 + bj * HALF);
#pragma unroll
        for (int ai = 0; ai < 2; ++ai) {
#pragma unroll
            for (int m = 0; m < 4; ++m) { const int row = row0 + ai * HALF + m * 16;
                float ss = 0.f;
                f32x4 xs[2][2];
#pragma unroll
                for (int bj = 0; bj < 2; ++bj) { const u32x4 xi = xin[m][bj];
                    f32x4 x0 = acc[ai][bj][m][0] + bv[bj][0], x1 = acc[ai][bj][m][1] + bv[bj][1];
                    x0[0] += __builtin_bit_cast(float, xi[0] << 16); x0[1] += __builtin_bit_cast(float, xi[0] & 0xffff0000u); x0[2] += __builtin_bit_cast(float, xi[1] << 16); x0[3] += __builtin_bit_cast(float, xi[1] & 0xffff0000u);
                    x1[0] += __builtin_bit_cast(float, xi[2] << 16); x1[1] += __builtin_bit_cast(float, xi[2] & 0xffff0000u); x1[2] += __builtin_bit_cast(float, xi[3] << 16); x1[3] += __builtin_bit_cast(float, xi[3] & 0xffff0000u);
                    xs[bj][0] = x0; xs[bj][1] = x1; }
                if (ai == 0) {
#pragma unroll
                    for (int bj = 0; bj < 2; ++bj) xin[m][bj] = *(const u32x4*)(XN + (size_t)(row0 + HALF + m * 16) * ldc + col0 + bj * HALF); }
#pragma unroll
                for (int bj = 0; bj < 2; ++bj) { const f32x4 x0 = xs[bj][0], x1 = xs[bj][1];
                    if (OUT) { float* op = OUT + (size_t)row * ldc + col0 + bj * HALF; *(f32x4*)op = x0; *(f32x4*)(op + 4) = x1; }
                    else { u32x4 w; w.x = cvt_pk_bf16(x0[0], x0[1]); w.y = cvt_pk_bf16(x0[2], x0[3]); w.z = cvt_pk_bf16(x1[0], x1[1]); w.w = cvt_pk_bf16(x1[2], x1[3]);
                        *(u32x4*)(XN + (size_t)row * ldc + col0 + bj * HALF) = w;
                        const float r0 = __builtin_bit_cast(float, w.x << 16), r1 = __builtin_bit_cast(float, w.x & 0xffff0000u), r2 = __builtin_bit_cast(float, w.y << 16), r3 = __builtin_bit_cast(float, w.y & 0xffff0000u);
                        const float r4 = __builtin_bit_cast(float, w.z << 16), r5 = __builtin_bit_cast(float, w.z & 0xffff0000u), r6 = __builtin_bit_cast(float, w.w << 16), r7 = __builtin_bit_cast(float, w.w & 0xffff0000u);
                        ss += ((r0 * r0 + r1 * r1) + (r2 * r2 + r3 * r3)) + ((r4 * r4 + r5 * r5) + (r6 * r6 + r7 * r7)); } }
                if (rss) {
                    { const unsigned us = __builtin_bit_cast(unsigned, ss); const auto r16 = __builtin_amdgcn_permlane16_swap(us, us, false, false); ss = __builtin_bit_cast(float, (unsigned)r16[0]) + __builtin_bit_cast(float, (unsigned)r16[1]); }
                    { const unsigned us = __builtin_bit_cast(unsigned, ss); const auto r32 = __builtin_amdgcn_permlane32_swap(us, us, false, false); ss = __builtin_bit_cast(float, (unsigned)r32[0]) + __builtin_bit_cast(float, (unsigned)r32[1]); }
                    if (fq == 0) part[(ai * HALF + wr * 64 + m * 16 + fr) * 4 + wc] = ss; } }
            asm volatile("" ::: "memory"); }
        if (rss) {
            asm volatile("s_waitcnt lgkmcnt(0)" ::: "memory"); __builtin_amdgcn_s_barrier(); asm volatile("" ::: "memory");
            if (wr == 0) { const int r = wc * 64 + fr + 16 * fq; const f32x4 p4 = *(const PG8_LAS f32x4*)(part + r * 4); rss[(size_t)(u.pm * BM + r) * 8 + u.pn] = (p4[0] + p4[1]) + (p4[2] + p4[3]); }
        }
    }
};
struct EpiTaps {
    static constexpr bool PERM = true, AFTER_DRAIN = false;
    unsigned short* O; int ldc;
    __device__ __forceinline__ void prefetch(const Unit&, int, int) const {}
    __device__ __forceinline__ void operator()(const f32x4 (&acc)[2][2][4][2], const Unit& u, int wr, int wc, int fr, int fq) const {
        const int row0 = u.pm * BM + wr * 64 + fr, col0 = u.pn * BM + wc * 32 + 8 * fq;
        float tt[2][8];
#pragma unroll
        for (int bj = 0; bj < 2; ++bj)
#pragma unroll
            for (int e = 0; e < 8; ++e) { const int i = col0 + bj * HALF + e; tt[bj][e] = (i < 8192) ? (float)i * (1.0f / 8191.0f) : (float)(i - 8192) * (1.0f / 16383.0f); }
#pragma unroll
        for (int ai = 0; ai < 2; ++ai)
#pragma unroll
            for (int m = 0; m < 4; ++m) { const int row = row0 + ai * HALF + m * 16; unsigned short* rowp = O + (size_t)row * ldc + col0;
                const float delta = 3.0701134573253944f + (float)(row & 2047) * (float)((15.350567286626973 - 3.0701134573253944) / 2047.0);
                const float nd = -1.4426950408889634f * delta;
#pragma unroll
                for (int bj = 0; bj < 2; ++bj) { const f32x4 v0 = acc[ai][bj][m][0], v1 = acc[ai][bj][m][1];
                    float r[8];
#pragma unroll
                    for (int e = 0; e < 4; ++e) { r[e] = v0[e] * __builtin_amdgcn_exp2f(tt[bj][e] * nd); r[4 + e] = v1[e] * __builtin_amdgcn_exp2f(tt[bj][4 + e] * nd); }
                    u32x4 w; w.x = cvt_pk_f16(r[0], r[1]); w.y = cvt_pk_f16(r[2], r[3]); w.z = cvt_pk_f16(r[4], r[5]); w.w = cvt_pk_f16(r[6], r[7]);
                    *(u32x4*)(rowp + bj * HALF) = w; } }
    }
};
template <class Epi, class Sched, bool ALIGN_EPI = false, bool SP2 = false>
__device__ __forceinline__ void gemm_phase(PG8_LAS unsigned char* lds, const Gemm g, const Sched& S, const Epi& E, const int wave_id) {
    int tid_; asm volatile("v_mbcnt_lo_u32_b32 %0, -1, 0\n\tv_mbcnt_hi_u32_b32 %0, -1, %0" : "=v"(tid_)); tid_ += wave_id * 64;
    const int tid = tid_, wid = __builtin_amdgcn_readfirstlane(tid >> 6), lane = tid & 63, wr = wid >> 2, wc = wid & 3, fr = lane & 15, fq = lane >> 4;
    const int K = g.K, nt = K / BK;
    unsigned voffA[2], voffB[2];
#pragma unroll
    for (int i = 0; i < 2; ++i) { int R, C; stage_rc(tid * 16 + i * 8192, R, C); const int Rb = Epi::PERM ? ((R & ~31) + perm32(R & 31)) : R;
        voffA[i] = (unsigned)(R * K + C) * 2u; voffB[i] = (unsigned)(Rb * K + C) * 2u; }
    const size_t kstep = (size_t)(BK * 2);
    const size_t hstep = (size_t)HALF * K * 2;
    const size_t tstep = 2 * hstep;
    const unsigned ldsw = (unsigned)wid * 1024u;
    const int aoff = lds_byte(wr * 64 + fr, fq * 8), boff = lds_byte(wc * 32 + fr, fq * 8);
#define PG8_SA(b, h) (((b) * 2 + (h)) * HTB)
#define PG8_SB(b, h) ((4 + (b) * 2 + (h)) * HTB)
#define PG8_STAGE(bufoff, gbase, voff) do { _Pragma("unroll") for (int _i = 0; _i < 2; ++_i) \
        __builtin_amdgcn_global_load_lds((const unsigned*)((const char*)(gbase) + (voff)[_i]), (PG8_LAS unsigned*)(lds + (bufoff) + ldsw + _i * 8192), 16, 0, 0); } while (0)
#define PG8_LDA(dst, b, h) do { _Pragma("unroll") for (int m = 0; m < 4; ++m) _Pragma("unroll") for (int k = 0; k < 2; ++k) dst[m][k] = *(const PG8_LAS bf16x8*)(lds + PG8_SA(b, h) + aoff + m * 2048 + k * 1024); } while (0)
#define PG8_LDB(dst, b, h) do { _Pragma("unroll") for (int n = 0; n < 2; ++n) _Pragma("unroll") for (int k = 0; k < 2; ++k) dst[n][k] = *(const PG8_LAS bf16x8*)(lds + PG8_SB(b, h) + boff + n * 2048 + k * 1024); } while (0)
#define PG8_MMA(ai, bj, At, Bt) do { __builtin_amdgcn_s_setprio(1); _Pragma("unroll") for (int m = 0; m < 4; ++m) _Pragma("unroll") for (int n = 0; n < 2; ++n) _Pragma("unroll") for (int k = 0; k < 2; ++k) \
        acc[ai][bj][m][n] = __builtin_amdgcn_mfma_f32_16x16x32_bf16(Bt[n][k], At[m][k], acc[ai][bj][m][n], 0, 0, 0); __builtin_amdgcn_s_setprio(0); } while (0)
#define PG8_WAIT_V(n) asm volatile("s_waitcnt vmcnt(" #n ")" ::: "memory")
#define PG8_WAIT_L(n) asm volatile("s_waitcnt lgkmcnt(" #n ")" ::: "memory")
#define PG8_BAR __builtin_amdgcn_s_barrier()
#define PG8_SCHED __builtin_amdgcn_sched_barrier(0)
    Unit cur, nxt; int ui = 0;
    if (!S.next(0, cur)) return;
    E.prefetch(cur, wid, lane);
    f32x4 acc[2][2][4][2];
#pragma unroll
    for (int a = 0; a < 2; ++a)
#pragma unroll
        for (int b = 0; b < 2; ++b)
#pragma unroll
            for (int m = 0; m < 4; ++m)
#pragma unroll
                for (int n = 0; n < 2; ++n) acc[a][b][m][n] = (f32x4){0.f, 0.f, 0.f, 0.f};
    bf16x8 At[4][2], B0[2][2], B1[2][2];
    const char* cA = (const char*)g.A + (size_t)cur.pm * tstep; const char* cB = (const char*)g.Bt + (size_t)cur.pn * tstep;
    S.a_ready(cur);
    if constexpr (SP2) {
        PG8_STAGE(PG8_SB(0, 0), cB, voffB); PG8_STAGE(PG8_SB(0, 1), cB + hstep, voffB); PG8_STAGE(PG8_SA(0, 0), cA, voffA); PG8_STAGE(PG8_SA(0, 1), cA + hstep, voffA);
        if (wr == 1) PG8_BAR;
        PG8_WAIT_V(2); PG8_BAR;
        PG8_STAGE(PG8_SB(1, 0), cB + kstep, voffB); PG8_STAGE(PG8_SA(1, 0), cA + kstep, voffA); PG8_STAGE(PG8_SB(1, 1), cB + hstep + kstep, voffB);
        PG8_WAIT_V(6); PG8_BAR;
    } else {
        PG8_STAGE(PG8_SB(0, 0), cB, voffB); PG8_STAGE(PG8_SA(0, 0), cA, voffA); PG8_STAGE(PG8_SB(0, 1), cB + hstep, voffB); PG8_STAGE(PG8_SA(0, 1), cA + hstep, voffA);
        if (wr == 1) PG8_BAR;
        PG8_WAIT_V(4); PG8_BAR;
        PG8_STAGE(PG8_SB(1, 0), cB + kstep, voffB); PG8_STAGE(PG8_SA(1, 0), cA + kstep, voffA); PG8_STAGE(PG8_SB(1, 1), cB + hstep + kstep, voffB);
        PG8_WAIT_V(6); PG8_BAR;
    }
    for (;;) {
        const bool has_next = S.next(ui + 1, nxt);
        const char* nA = has_next ? (const char*)g.A + (size_t)nxt.pm * tstep : cA; const char* nB = has_next ? (const char*)g.Bt + (size_t)nxt.pn * tstep : cB;
        for (int t = 0; t < nt; t += 2) {
            const bool last = (t == nt - 2);
            const char* a1 = cA + (size_t)(t + 1) * kstep;
            const char* a2 = last ? nA : cA + (size_t)(t + 2) * kstep; const char* b2 = last ? nB : cB + (size_t)(t + 2) * kstep;
            const char* a3 = a2 + kstep; const char* b3 = b2 + kstep;
            if (last && has_next) S.a_ready(nxt);
            if constexpr (SP2) {
            PG8_LDB(B0, 0, 0); PG8_LDB(B1, 0, 1); PG8_SCHED; PG8_LDA(At, 0, 0); PG8_STAGE(PG8_SA(1, 1), a1 + hstep, voffA);
            PG8_WAIT_V(8); PG8_WAIT_L(0); PG8_BAR; PG8_MMA(0, 0, At, B0); PG8_MMA(0, 1, At, B1); PG8_BAR; PG8_SCHED;
            PG8_LDA(At, 0, 1); PG8_STAGE(PG8_SB(0, 0), b2, voffB); PG8_STAGE(PG8_SB(0, 1), b2 + hstep, voffB); PG8_STAGE(PG8_SA(0, 0), a2, voffA);
            PG8_WAIT_V(8); PG8_WAIT_L(0); PG8_BAR; PG8_MMA(1, 0, At, B0); PG8_MMA(1, 1, At, B1); PG8_BAR; PG8_SCHED;
            PG8_LDB(B0, 1, 0); PG8_LDB(B1, 1, 1); PG8_SCHED; PG8_LDA(At, 1, 0); PG8_STAGE(PG8_SA(0, 1), a2 + hstep, voffA);
            PG8_WAIT_V(8); PG8_WAIT_L(0); PG8_BAR; PG8_MMA(0, 0, At, B0); PG8_MMA(0, 1, At, B1); PG8_BAR; PG8_SCHED;
            PG8_LDA(At, 1, 1); PG8_STAGE(PG8_SB(1, 0), b3, voffB); PG8_STAGE(PG8_SB(1, 1), b3 + hstep, voffB); PG8_STAGE(PG8_SA(1, 0), a3, voffA);
            PG8_WAIT_V(8); PG8_WAIT_L(0); PG8_BAR; PG8_MMA(1, 0, At, B0); PG8_MMA(1, 1, At, B1); PG8_BAR; PG8_SCHED;
            } else {
            PG8_LDB(B0, 0, 0); PG8_SCHED; PG8_LDA(At, 0, 0); PG8_STAGE(PG8_SA(1, 1), a1 + hstep, voffA);
            PG8_WAIT_L(8); PG8_BAR; PG8_WAIT_L(0); PG8_MMA(0, 0, At, B0); PG8_BAR; PG8_SCHED;
            PG8_LDB(B1, 0, 1); PG8_STAGE(PG8_SB(0, 0), b2, voffB);
            PG8_BAR; PG8_WAIT_L(0); PG8_MMA(0, 1, At, B1); PG8_BAR;
            PG8_LDA(At, 0, 1); PG8_STAGE(PG8_SA(0, 0), a2, voffA);
            PG8_BAR; PG8_WAIT_L(0); PG8_MMA(1, 0, At, B0); PG8_BAR; PG8_SCHED;
            PG8_STAGE(PG8_SB(0, 1), b2 + hstep, voffB);
            PG8_WAIT_V(6); PG8_BAR; PG8_MMA(1, 1, At, B1); PG8_BAR;
            PG8_LDB(B0, 1, 0); PG8_SCHED; PG8_LDA(At, 1, 0); PG8_STAGE(PG8_SA(0, 1), a2 + hstep, voffA);
            PG8_WAIT_L(8); PG8_BAR; PG8_WAIT_L(0); PG8_MMA(0, 0, At, B0); PG8_BAR; PG8_SCHED;
            PG8_LDB(B1, 1, 1); PG8_STAGE(PG8_SB(1, 0), b3, voffB);
            PG8_BAR; PG8_WAIT_L(0); PG8_MMA(0, 1, At, B1); PG8_BAR;
            PG8_LDA(At, 1, 1); PG8_STAGE(PG8_SA(1, 0), a3, voffA);
            PG8_BAR; PG8_WAIT_L(0); PG8_MMA(1, 0, At, B0); PG8_BAR; PG8_SCHED;
            PG8_STAGE(PG8_SB(1, 1), b3 + hstep, voffB);
            PG8_WAIT_V(6); PG8_BAR; PG8_MMA(1, 1, At, B1); PG8_BAR;
            }
        }
        if constexpr (ALIGN_EPI) { if (wr == 0) PG8_BAR; }
        if constexpr (!Epi::AFTER_DRAIN) { E(acc, cur, wr, wc, fr, fq); if (has_next) E.prefetch(nxt, wid, lane); S.done(cur); }
        if (!has_next) break;
#pragma unroll
        for (int a = 0; a < 2; ++a)
#pragma unroll
            for (int b = 0; b < 2; ++b)
#pragma unroll
                for (int m = 0; m < 4; ++m)
#pragma unroll
                    for (int n = 0; n < 2; ++n) acc[a][b][m][n] = (f32x4){0.f, 0.f, 0.f, 0.f};
        cur = nxt; cA = nA; cB = nB; ++ui;
        if constexpr (ALIGN_EPI) { if (wr == 1) PG8_BAR; }
    }
    PG8_WAIT_V(0);
    if constexpr (!ALIGN_EPI) { if (wr == 0) PG8_BAR; }
    PG8_BAR;
    if constexpr (Epi::AFTER_DRAIN) { E.fused(acc, cur, wr, wc, fr, fq, lds, wid, lane); S.done(cur); }
#undef PG8_SA
#undef PG8_SB
#undef PG8_STAGE
#undef PG8_LDA
#undef PG8_LDB
#undef PG8_MMA
#undef PG8_WAIT_V
#undef PG8_WAIT_L
#undef PG8_BAR
#undef PG8_SCHED
}
}

#define FC_AS3 __attribute__((address_space(3)))
#if defined(__HIP_DEVICE_COMPILE__)
#define FC_SINCOS(rev, s, c) do { (s) = __builtin_amdgcn_sinf(rev); (c) = __builtin_amdgcn_cosf(rev); } while (0)
#define FC_OPAQUE(v) asm volatile("" : "+v"(v))
#else
#define FC_OPAQUE(v) do {} while (0)
#include <cmath>
#define FC_SINCOS(rev, s, c) do { (s) = sinf(6.283185307179586f * (rev)); (c) = cosf(6.283185307179586f * (rev)); } while (0)
#endif
#include <utility>
#ifndef FC_HD
#define FC_HD __host__ __device__ __forceinline__
#endif
namespace fc {
typedef float cpx __attribute__((ext_vector_type(2)));
typedef float f4 __attribute__((ext_vector_type(4)));
#ifndef FC_AS3
#define FC_AS3
#endif
typedef FC_AS3 cpx* lptr;
typedef const FC_AS3 cpx* clptr;
FC_HD cpx cmul_c(cpx a, cpx b) { return cpx{a.x * b.x - a.y * b.y, a.x * b.y + a.y * b.x}; }
#if defined(__HIP_DEVICE_COMPILE__) && defined(FC_ASM_CMUL)
__device__ __forceinline__ cpx cmul(cpx a, cpx b) { cpx t, r;
    asm("v_pk_mul_f32 %0, %2, %3 op_sel:[1,1] op_sel_hi:[1,0]\n\tv_pk_fma_f32 %1, %2, %3, %0 op_sel:[0,0,0] op_sel_hi:[0,1,1] neg_lo:[0,0,1] neg_hi:[0,0,0]" : "=&v"(t), "=&v"(r) : "v"(a), "v"(b));
    return r; }
#else
FC_HD cpx cmul(cpx a, cpx b) { return cmul_c(a, b); }
#endif
#if defined(__HIP_DEVICE_COMPILE__) && defined(FC_ASM_CMULK)
__device__ __forceinline__ cpx cmul_k(cpx a, cpx b) { cpx t, r;
    asm("v_pk_mul_f32 %0, %2, %3 op_sel:[1,1] op_sel_hi:[1,0]\n\tv_pk_fma_f32 %1, %2, %3, %0 op_sel:[0,0,0] op_sel_hi:[0,1,1] neg_lo:[0,0,1] neg_hi:[0,0,0]" : "=&v"(t), "=&v"(r) : "v"(a), "v"(b));
    return r; }
#else
FC_HD cpx cmul_k(cpx a, cpx b) { return cmul_c(a, b); }
#endif
FC_HD cpx cadd(cpx a, cpx b) { return cpx{a.x + b.x, a.y + b.y}; }
FC_HD cpx csub(cpx a, cpx b) { return cpx{a.x - b.x, a.y - b.y}; }
FC_HD cpx cconj(cpx a) { return cpx{a.x, -a.y}; }
FC_HD constexpr int padi(int e) { return e + (e >> 4); }
FC_HD constexpr float c32(int m) {
    switch (m) { case 0: return 1.0f; case 1: return 0.98078528040323043f; case 2: return 0.92387953251128674f; case 3: return 0.83146961230254524f; case 4: return 0.70710678118654752f;
        case 5: return 0.55557023301960218f; case 6: return 0.38268343236508977f; case 7: return 0.19509032201612825f; case 8: return 0.0f; case 9: return -0.19509032201612825f;
        case 10: return -0.38268343236508977f; case 11: return -0.55557023301960218f; case 12: return -0.70710678118654752f; case 13: return -0.83146961230254524f; case 14: return -0.92387953251128674f;
        default: return -0.98078528040323043f; } }
FC_HD constexpr float s32(int m) {
    switch (m) { case 0: return 0.0f; case 1: return 0.19509032201612825f; case 2: return 0.38268343236508977f; case 3: return 0.55557023301960218f; case 4: return 0.70710678118654752f;
        case 5: return 0.83146961230254524f; case 6: return 0.92387953251128674f; case 7: return 0.98078528040323043f; case 8: return 1.0f; case 9: return 0.98078528040323043f;
        case 10: return 0.92387953251128674f; case 11: return 0.83146961230254524f; case 12: return 0.70710678118654752f; case 13: return 0.55557023301960218f; case 14: return 0.38268343236508977f;
        default: return 0.19509032201612825f; } }
template <int R> FC_HD constexpr int brev(int v) { int r = 0; for (int b = 1; b < R; b <<= 1) { r = (r << 1) | (v & 1); v >>= 1; } return r; }
template <int R, bool INV, int H, int P, bool ZU> FC_HD void dft_bfly(cpx (&c)[R]) {
    constexpr int blk = (P / H) * 2 * H, i = P % H, m = i * (16 / H);
    const cpx a = c[blk + i];
    cpx d;
    if constexpr (ZU && H == R / 2) d = a;
    else { const cpx b = c[blk + i + H]; c[blk + i] = cadd(a, b);
#if defined(__HIP_DEVICE_COMPILE__) && defined(FC_ASM_CMUL)
        if constexpr (m == 8) {
            cpx r;
            if (INV) asm("v_pk_add_f32 %0, %1, %2 op_sel:[1,1] op_sel_hi:[0,0] neg_lo:[1,0] neg_hi:[0,1]" : "=v"(r) : "v"(a), "v"(b));
            else     asm("v_pk_add_f32 %0, %1, %2 op_sel:[1,1] op_sel_hi:[0,0] neg_lo:[0,1] neg_hi:[1,0]" : "=v"(r) : "v"(a), "v"(b));
            c[blk + i + H] = r; return; }
#endif
        d = csub(a, b); }
    if constexpr (m == 0) c[blk + i + H] = d;
    else if constexpr (m == 8) c[blk + i + H] = INV ? cpx{-d.y, d.x} : cpx{d.y, -d.x};
    else { constexpr float wc = c32(m), ws = INV ? s32(m) : -s32(m); c[blk + i + H] = cmul_k(d, cpx{wc, ws}); }
}
template <int R, bool INV, int H, bool ZU, int... Ps> FC_HD void dft_stage(cpx (&c)[R], std::integer_sequence<int, Ps...>) { (dft_bfly<R, INV, H, Ps, ZU>(c), ...); }
template <int R, bool INV, int H, bool ZU> FC_HD void dft_stages(cpx (&c)[R]) {
    dft_stage<R, INV, H, ZU>(c, std::make_integer_sequence<int, R / 2>{});
    if constexpr (H > 1) dft_stages<R, INV, H / 2, ZU>(c);
}
template <int R, bool INV, bool ZU = false> FC_HD void dft_reg(cpx (&c)[R]) { dft_stages<R, INV, R / 2, ZU>(c); }
template <int M, int S, int R, bool INV, int NT, int ZH = 0, bool WM = false> FC_HD void fft_pass(lptr lds, int tid) {
    constexpr int T = S / R, IT = (M / R) / NT;
    FC_OPAQUE(tid);
    for (int it = 0; it < (IT > 0 ? IT : 1); ++it) {
        const int b = WM ? (tid & ~63) * IT + (tid & 63) + 64 * it : tid + NT * it;
        if (b >= M / R) break;
        const int j = b % T, blk = b / T, base = blk * S + j;
        static_assert(T % 16 == 0 || (T == 1 && R <= 16), "padded index must be linear in k");
        constexpr int TS = (T % 16 == 0) ? T + T / 16 : 1;
        const int pb = padi(base);
        cpx c[R];
#pragma unroll
        for (int k = 0; k < R; ++k) { if (ZH == 1 && k >= R / 2) c[k] = cpx{0.f, 0.f}; else c[k] = lds[pb + k * TS]; }
        cpx w1 = cpx{1.f, 0.f};
        if (T > 1) { float s, co; FC_SINCOS((float)j * (1.0f / (float)S), s, co); w1 = cpx{co, INV ? s : -s}; }
        cpx w4 = cpx{1.f, 0.f}, cur[4];
        if (T > 1) { const cpx w2 = cmul_c(w1, w1); cur[0] = cpx{1.f, 0.f}; cur[1] = w1; cur[2] = w2; cur[3] = cmul_c(w2, w1); w4 = cmul_c(w2, w2); }
        if (INV && T > 1) {
#pragma unroll
            for (int k0 = 0; k0 < R; k0 += 4) {
#pragma unroll
                for (int i = 0; i < 4; ++i) { if (k0 + i > 0) c[k0 + i] = cmul(c[k0 + i], cur[i]); if (k0 + 4 < R) cur[i] = cmul(cur[i], w4); }
            }
        }
        dft_reg<R, INV, ZH == 1>(c);
        if (!INV && T > 1) {
#pragma unroll
            for (int k0 = 0; k0 < R; k0 += 4) {
#pragma unroll
                for (int i = 0; i < 4; ++i) { if (k0 + i > 0) c[brev<R>(k0 + i)] = cmul(c[brev<R>(k0 + i)], cur[i]); if (k0 + 4 < R) cur[i] = cmul(cur[i], w4); }
            }
        }
#pragma unroll
        for (int k = 0; k < (ZH == 2 ? R / 2 : R); ++k) lds[pb + k * TS] = c[brev<R>(k)];
    }
}
template <int M> struct Radix;
template <> struct Radix<8192>  { static constexpr int R1 = 32, R2 = 16, R3 = 16; };
template <> struct Radix<16384> { static constexpr int R1 = 32, R2 = 32, R3 = 16; };
template <int M> FC_HD int fpos(int f) { typedef Radix<M> X; return (f % X::R1) * (M / X::R1) + ((f / X::R1) % X::R2) * X::R3 + (f / (X::R1 * X::R2)); }
template <int M> FC_HD int qfreq(int q) { typedef Radix<M> X; const int k3 = q % (X::R3 / 2), k2 = (q / (X::R3 / 2)) % X::R2, k1 = q / ((X::R3 / 2) * X::R2); return k1 + X::R1 * (k2 + X::R2 * k3); }

#if defined(__HIP_DEVICE_COMPILE__)
#define FC_WSYNC asm volatile("s_waitcnt lgkmcnt(0)" ::: "memory")
#else
#define FC_WSYNC do {} while (0)
#endif
#define FC_FWD(M, NT, lds, tid, SYNC) do { typedef fc::Radix<M> X_; fc::fft_pass<M, M, X_::R1, false, NT>(lds, tid); SYNC; fc::fft_pass<M, M / X_::R1, X_::R2, false, NT, 0, true>(lds, tid); FC_WSYNC; \
    fc::fft_pass<M, X_::R3, X_::R3, false, NT, 0, true>(lds, tid); SYNC; } while (0)
#define FC_FWD12Z(M, NT, lds, tid, SYNC) do { typedef fc::Radix<M> X_; fc::fft_pass<M, M, X_::R1, false, NT, 1>(lds, tid); SYNC; fc::fft_pass<M, M / X_::R1, X_::R2, false, NT, 0, true>(lds, tid); FC_WSYNC; } while (0)
#define FC_FWD3(M, NT, lds, tid, SYNC) do { typedef fc::Radix<M> X_; fc::fft_pass<M, X_::R3, X_::R3, false, NT, 0, true>(lds, tid); SYNC; } while (0)
#define FC_INVZ(M, NT, lds, tid, SYNC) do { typedef fc::Radix<M> X_; fc::fft_pass<M, X_::R3, X_::R3, true, NT, 0, true>(lds, tid); FC_WSYNC; fc::fft_pass<M, M / X_::R1, X_::R2, true, NT, 0, true>(lds, tid); SYNC; \
    fc::fft_pass<M, M, X_::R1, true, NT, 2>(lds, tid); SYNC; } while (0)

#if defined(__HIP_DEVICE_COMPILE__) && defined(FC_ASM_CMUL)
__device__ __forceinline__ void untangle(cpx Zf, cpx Zg, cpx w, cpx& Xf, cpx& Xg) {
    cpx A, D, t, u;
    asm("v_pk_add_f32 %0, %6, %7 neg_hi:[0,1]\n\t"
        "v_pk_add_f32 %1, %6, %7 neg_lo:[0,1]\n\t"
        "v_pk_mul_f32 %2, %8, %1 op_sel:[1,1] op_sel_hi:[1,0]\n\t"
        "v_pk_fma_f32 %3, %8, %1, %2 op_sel:[0,0,0] op_sel_hi:[0,1,1] neg_lo:[0,0,1] neg_hi:[0,0,0]\n\t"
        "v_pk_add_f32 %4, %0, %3 op_sel:[0,1] op_sel_hi:[1,0] neg_hi:[0,1]\n\t"
        "v_pk_add_f32 %5, %0, %3 op_sel:[0,1] op_sel_hi:[1,0] neg_lo:[0,1] neg_hi:[1,1]"
        : "=&v"(A), "=&v"(D), "=&v"(t), "=&v"(u), "=&v"(Xf), "=&v"(Xg) : "v"(Zf), "v"(Zg), "v"(w));
}
__device__ __forceinline__ void retangle(cpx Yf, cpx Yg, cpx w, cpx& Zf, cpx& Zg) {
    cpx P, D, t, u;
    asm("v_pk_add_f32 %0, %6, %7 neg_hi:[0,1]\n\t"
        "v_pk_add_f32 %1, %6, %7 neg_lo:[0,1]\n\t"
        "v_pk_mul_f32 %2, %1, %8 op_sel:[1,1] op_sel_hi:[0,1]\n\t"
        "v_pk_fma_f32 %3, %1, %8, %2 op_sel:[0,0,0] op_sel_hi:[1,0,1] neg_lo:[0,0,0] neg_hi:[0,0,1]\n\t"
        "v_pk_add_f32 %4, %0, %3 op_sel:[0,1] op_sel_hi:[1,0] neg_lo:[0,1]\n\t"
        "v_pk_add_f32 %5, %0, %3 op_sel:[0,1] op_sel_hi:[1,0] neg_hi:[1,0]"
        : "=&v"(P), "=&v"(D), "=&v"(t), "=&v"(u), "=&v"(Zf), "=&v"(Zg) : "v"(Yf), "v"(Yg), "v"(w));
}
#else
FC_HD void untangle(cpx Zf, cpx Zg, cpx w, cpx& Xf, cpx& Xg) {
    const cpx A = cpx{Zf.x + Zg.x, Zf.y - Zg.y}, D = cpx{Zf.x - Zg.x, Zf.y + Zg.y};
    const cpx t = cmul_c(w, D);
    Xf = cpx{A.x + t.y, A.y - t.x}; Xg = cpx{A.x - t.y, -A.y - t.x};
}
FC_HD void retangle(cpx Yf, cpx Yg, cpx w, cpx& Zf, cpx& Zg) {
    const cpx P = cpx{Yf.x + Yg.x, Yf.y - Yg.y}, D = cpx{Yf.x - Yg.x, Yf.y + Yg.y};
    const cpx u = cpx{D.x * w.x + D.y * w.y, D.y * w.x - D.x * w.y};
    Zf = cpx{P.x - u.y, P.y + u.x}; Zg = cpx{P.x + u.y, -P.y + u.x};
}
#endif
template <int M> FC_HD cpx wstep() { return M == 8192 ? cpx{0.9999997058628822f, -0.0007669903187427045f} : cpx{0.9999999264657179f, -0.00038349518757139556f}; }
template <int M, int NT> struct PairIdx {
    typedef Radix<M> X;
    static constexpr int NJ = (M / 2) / NT, PS = 2 * (M / X::R1), PSP = PS + PS / 16;
    static_assert(NT == (X::R3 / 2) * X::R2 * 2, "thread count vs radix split");
    int f0, pf0, pg0, pgA;
    FC_HD void init(int tid) {
        const int k3 = tid % (X::R3 / 2), k2 = (tid / (X::R3 / 2)) % X::R2, k1b = tid / ((X::R3 / 2) * X::R2);
        f0 = k1b + X::R1 * (k2 + X::R2 * k3);
        pf0 = padi(k1b * (M / X::R1) + k2 * X::R3 + k3);
        pg0 = padi(fpos<M>((M - f0) % M));
        pgA = padi((X::R1 - k1b) * (M / X::R1) + (X::R2 - 1 - k2) * X::R3 + (X::R3 - 1 - k3));
    }
    FC_HD int pf(int jj) const { return pf0 + jj * PSP; }
    FC_HD int pg(int jj) const { return jj == 0 ? pg0 : pgA - jj * PSP; }
};
template <int M, int NT> FC_HD void filter_pass(clptr lds, int tid, float sc, f4* kb) {
    FC_OPAQUE(tid);
    PairIdx<M, NT> ix; ix.init(tid);
    float s, co; FC_SINCOS((float)ix.f0 * (0.5f / (float)M), s, co); cpx w = cpx{co, -s}; const cpx d = wstep<M>();
#pragma unroll
    for (int jj = 0; jj < PairIdx<M, NT>::NJ; ++jj) {
        const cpx Zf = lds[ix.pf(jj)], Zg = lds[ix.pg(jj)];
        cpx Xf, Xg; untangle(Zf, Zg, w, Xf, Xg);
        kb[jj * NT + tid] = f4{Xf.x * sc, Xf.y * sc, Xg.x * sc, Xg.y * sc};
        w = cmul_c(w, d);
    }
    if (tid == 0) { const cpx Z = lds[padi(fpos<M>(M / 2))]; cpx Xf, Xg; untangle(Z, Z, cpx{0.f, -1.f}, Xf, Xg);
        kb[M / 2] = f4{Xf.x * sc, Xf.y * sc, Xg.x * sc, Xg.y * sc}; }
}
template <int M, int NT> struct KRegs { f4 k[(M / 2) / NT]; f4 kx; };
template <int M, int NT> FC_HD void k_prefetch(const f4* kb, int tid, KRegs<M, NT>& r) {
#pragma unroll
    for (int jj = 0; jj < (M / 2) / NT; ++jj) r.k[jj] = kb[jj * NT + tid];
    r.kx = kb[M / 2];
}
template <int M, int NT> FC_HD void mult_pass(lptr lds, int tid, const KRegs<M, NT>& r) {
    FC_OPAQUE(tid);
    PairIdx<M, NT> ix; ix.init(tid);
    float s, co; FC_SINCOS((float)ix.f0 * (0.5f / (float)M), s, co); cpx w = cpx{co, -s}; const cpx d = wstep<M>();
#pragma unroll
    for (int jj = 0; jj < PairIdx<M, NT>::NJ; ++jj) {
        const int pf = ix.pf(jj), pg = ix.pg(jj);
        const cpx Zf = lds[pf], Zg = lds[pg];
        cpx Xf, Xg; untangle(Zf, Zg, w, Xf, Xg);
        const f4 k = r.k[jj];
        const cpx Yf = cmul(Xf, cpx{k[0], k[1]}), Yg = cmul(Xg, cpx{k[2], k[3]});
        cpx Of, Og; retangle(Yf, Yg, w, Of, Og);
        lds[pf] = Of; if (jj != 0 || ix.f0 != 0) lds[pg] = Og;
        w = cmul_c(w, d);
    }
    if (tid == 0) { const int p = padi(fpos<M>(M / 2)); const cpx Z = lds[p]; const cpx w2 = cpx{0.f, -1.f}; cpx Xf, Xg; untangle(Z, Z, w2, Xf, Xg);
        const f4 k = r.kx; const cpx Yf = cmul(Xf, cpx{k[0], k[1]}), Yg = cmul(Xg, cpx{k[2], k[3]}); cpx Of, Og; retangle(Yf, Yg, w2, Of, Og); lds[p] = Of; }
}
}

constexpr int NWAVES = 8;
constexpr int D = 2048, NTOK = 49152, NTOKP = 32768, LP = 8192, LS = 16384, NBP = 4;
constexpr int DFF = 5632, NGU = 2 * DFF, NQKV = 3072, NHY = 3 * D;
constexpr int HT_ROWS = 8192, HT_COLS = LP + LS;
constexpr int NHEAD = 16, HD = 128, NKV = 4;
constexpr float EPS = 1e-6f;
#ifndef MK_PER_PHASE
#define MK_PER_PHASE 0
#endif
constexpr int NPHASE = 23;
#ifndef EN_MASK
#define EN_MASK 0xffff
#endif

constexpr size_t MiB = 1u << 20;
constexpr size_t WS_CTL = 0, CTL_ZERO_BYTES = 64 * 1024;
constexpr size_t WS_RSS = 1 * MiB;
constexpr size_t WS_WMA = 4 * MiB;
constexpr size_t WS_WMB = 28 * MiB;
constexpr size_t WS_WGU = 36 * MiB;
constexpr size_t WS_WDN = 80 * MiB;
constexpr size_t WS_A3X = 102 * MiB;
constexpr size_t WS_WOX = 126 * MiB;
constexpr size_t WS_XN = 134 * MiB;
constexpr size_t WS_HT = 326 * MiB;
constexpr size_t WS_BIG = 710 * MiB;
constexpr size_t WS_KB = 1286 * MiB;
constexpr int KB_ORDER = 8256;
constexpr int KB_BLOCK = 2 * KB_ORDER + 4096;
constexpr size_t WS_END = WS_KB + (size_t)256 * KB_BLOCK * 16;
static_assert(WS_END <= 1400 * MiB, "ws map");
constexpr int CW_BAR = 4096;

constexpr int LDS_BYTES = 147456;
constexpr int MISC_OFF = 146432;
constexpr int RED_OFF = 145408;
constexpr int PTAB_OFF = MISC_OFF + 256;

typedef __attribute__((address_space(3))) float pg8_las_f;
#define GAS __attribute__((address_space(1)))
#define LAS __attribute__((address_space(3)))
typedef unsigned short bf16;
typedef unsigned v4u __attribute__((ext_vector_type(4)));
typedef unsigned v2u __attribute__((ext_vector_type(2)));
typedef float f32x4 __attribute__((ext_vector_type(4)));
typedef float f32x16 __attribute__((ext_vector_type(16)));
typedef short bf16x8 __attribute__((ext_vector_type(8)));
typedef short s16x4 __attribute__((ext_vector_type(4)));
typedef GAS unsigned gu32;
#define RLX_AGENT __ATOMIC_RELAXED, __HIP_MEMORY_SCOPE_AGENT
#define LDS_WAIT() asm volatile("s_waitcnt lgkmcnt(0)" ::: "memory")
__device__ __forceinline__ unsigned f2bf(float f) { unsigned u = __builtin_bit_cast(unsigned, f); return (u + 0x7fffu + ((u >> 16) & 1u)) >> 16; }
__device__ __forceinline__ unsigned pk2(float lo, float hi) { unsigned r; asm("v_cvt_pk_bf16_f32 %0, %1, %2" : "=v"(r) : "v"(lo), "v"(hi)); return r; }
__device__ __forceinline__ float bf_lo(unsigned w) { return __builtin_bit_cast(float, w << 16); }
__device__ __forceinline__ float bf_hi(unsigned w) { return __builtin_bit_cast(float, w & 0xffff0000u); }
__device__ __forceinline__ float h2f(unsigned short h) { return (float)__builtin_bit_cast(_Float16, h); }
__device__ __forceinline__ float dpp_f(float v, int ctrl_sel) {
    const int b = __builtin_bit_cast(int, v); int r;
    if (ctrl_sel == 0) r = __builtin_amdgcn_update_dpp(0, b, 0xB1, 0xF, 0xF, true);
    else if (ctrl_sel == 1) r = __builtin_amdgcn_update_dpp(0, b, 0x4E, 0xF, 0xF, true);
    else if (ctrl_sel == 2) r = __builtin_amdgcn_update_dpp(0, b, 0x141, 0xF, 0xF, true);
    else r = __builtin_amdgcn_update_dpp(0, b, 0x140, 0xF, 0xF, true);
    return __builtin_bit_cast(float, r);
}
__device__ __forceinline__ float sum16(float v) { v += dpp_f(v, 0); v += dpp_f(v, 1); v += dpp_f(v, 2); v += dpp_f(v, 3); return v; }
__device__ __forceinline__ float sum_halves(float v) { const unsigned u = __builtin_bit_cast(unsigned, v); const auto rr = __builtin_amdgcn_permlane32_swap(u, u, false, false);
    return __builtin_bit_cast(float, (unsigned)rr[0]) + __builtin_bit_cast(float, (unsigned)rr[1]); }
__device__ __forceinline__ float max_halves(float v) { const unsigned u = __builtin_bit_cast(unsigned, v); const auto rr = __builtin_amdgcn_permlane32_swap(u, u, false, false);
    return fmaxf(__builtin_bit_cast(float, (unsigned)rr[0]), __builtin_bit_cast(float, (unsigned)rr[1])); }
__device__ __forceinline__ float rdlane_f(float v, int l) { return __builtin_bit_cast(float, __builtin_amdgcn_readlane(__builtin_bit_cast(int, v), l)); }
__device__ __forceinline__ float wave_sum(float v, int  ) { v = sum16(v); return (rdlane_f(v, 0) + rdlane_f(v, 16)) + (rdlane_f(v, 32) + rdlane_f(v, 48)); }

#define XB_TMO      128
#define XB_XCNT(j)  (256  + 64 * (j))
#define XB_XSUB(j)  (1280 + 64 * (j))
#define XB_XGEN(j)  (2304 + 64 * (j))
#define XB_TOP      3328
#define XB_TOPGEN   3392
#define XCD_BAR_WORDS 3456
#define XB_SPIN_CAP (1u << 18)

__device__ __forceinline__ unsigned xb_ld(unsigned* p)              { return __hip_atomic_load(p, __ATOMIC_RELAXED, __HIP_MEMORY_SCOPE_AGENT); }
__device__ __forceinline__ unsigned xb_add(unsigned* p, unsigned v) { return __hip_atomic_fetch_add(p, v, __ATOMIC_RELAXED, __HIP_MEMORY_SCOPE_AGENT); }
__device__ __forceinline__ unsigned xb_xcc_id() { return (unsigned)__builtin_amdgcn_s_getreg((3 << 11) | 20) & 0xFu; }
#define XB_SPIN(cond, bar) do { unsigned _sp = 0; while (cond) { __builtin_amdgcn_s_sleep(1); \
    if ((++_sp & 255u) == 0u) { if (xb_ld(&(bar)[XB_TMO])) break; if (_sp > XB_SPIN_CAP) { atomicAdd(&(bar)[XB_TMO], 1u); break; } } } } while (0)

struct XcdBarrier {
    unsigned* bar; unsigned x;
    volatile LAS unsigned* st;
};

__device__ __forceinline__ XcdBarrier xcd_barrier_post(unsigned* bar, volatile LAS unsigned* st) {
    XcdBarrier b; b.bar = bar; b.x = xb_xcc_id(); b.st = st;
    if (threadIdx.x == 0) (void)xb_add(&bar[XB_XCNT(b.x)], 1u);
    return b;
}
__device__ __forceinline__ void xcd_barrier_complete(unsigned* bar, unsigned x, unsigned& nloc, unsigned& nx) {
    const unsigned G = gridDim.x * gridDim.y * gridDim.z;
    unsigned sum, cnt, mine, sp = 0u;
    for (;;) {
        sum = 0u; cnt = 0u; mine = 0u;
#pragma unroll
        for (unsigned j = 0; j < 16; ++j) { const unsigned c = xb_ld(&bar[XB_XCNT(j)]); sum += c; cnt += (c > 0u) ? 1u : 0u; mine = (j == x) ? c : mine; }
        if (sum == G) break;
        __builtin_amdgcn_s_sleep(1);
        if ((++sp & 255u) == 0u) { if (xb_ld(&bar[XB_TMO])) break; if (sp > XB_SPIN_CAP) { atomicAdd(&bar[XB_TMO], 1u); break; } }
    }
    nloc = mine > 0u ? mine : 1u; nx = cnt > 0u ? cnt : 1u;
}

__device__ __forceinline__ void xcd_barrier(const XcdBarrier& b) {
    asm volatile("s_waitcnt vmcnt(0)" ::: "memory");
    __syncthreads();
    if (threadIdx.x == 0) {
        unsigned* bar = b.bar;
        __builtin_amdgcn_s_waitcnt(0);
        unsigned nloc = b.st[0], nx = b.st[1];
        if (nloc == 0u) { xcd_barrier_complete(bar, b.x, nloc, nx); b.st[0] = nloc; b.st[1] = nx; }
        const unsigned old = xb_add(&bar[XB_XSUB(b.x)], 1u);
        const unsigned gen = old / nloc;
        if (old + 1u == (gen + 1u) * nloc) {
            __builtin_amdgcn_fence(__ATOMIC_RELEASE, "agent");
            asm volatile("s_waitcnt vmcnt(0)" ::: "memory");
            const unsigned og = xb_add(&bar[XB_TOP], 1u);
            const unsigned tg = og / nx;
            if (og + 1u == (tg + 1u) * nx) xb_add(&bar[XB_TOPGEN], 1u);
            else XB_SPIN(xb_ld(&bar[XB_TOPGEN]) == tg, bar);
            __builtin_amdgcn_fence(__ATOMIC_ACQUIRE, "agent");
            xb_add(&bar[XB_XGEN(b.x)], 1u);
            asm volatile("s_waitcnt vmcnt(0)" ::: "memory");
        } else {
            XB_SPIN(xb_ld(&bar[XB_XGEN(b.x)]) == gen, bar);
            __builtin_amdgcn_fence(__ATOMIC_ACQUIRE, "agent");
            asm volatile("s_waitcnt vmcnt(0)" ::: "memory");
        }
    }
    __syncthreads();
}

struct Args {
    const float* in[27]; float* out; unsigned char* ws; int ph_lo, ph_hi, dry, pad;
};
struct Frame {
    LAS unsigned char* lds;
    int tid, lane, wave, vcu, G, bx;
    __device__ __forceinline__ const float* inp(int i) const {
        volatile LAS unsigned* t = (volatile LAS unsigned*)(lds + PTAB_OFF) + 2 * i;
        const unsigned lo = __builtin_amdgcn_readfirstlane(t[0]), hi = __builtin_amdgcn_readfirstlane(t[1]);
        return (const float*)(const GAS float*)(((unsigned long long)hi << 32) | lo);
    }
    __device__ __forceinline__ float* outp() const { return (float*)inp(27); }
    __device__ __forceinline__ unsigned char* wsp() const { return (unsigned char*)inp(28); }
};
#define OPAQUE_V(v) asm volatile("" : "+v"(v))
#define OPAQUE_S(v) asm volatile("" : "+s"(v))
#define PH_FRAME(Fp) Frame Fp = F; OPAQUE_S(Fp.lds); OPAQUE_S(Fp.wave); OPAQUE_S(Fp.vcu); OPAQUE_S(Fp.G); OPAQUE_S(Fp.bx); asm volatile("v_mbcnt_lo_u32_b32 %0, -1, 0\n\tv_mbcnt_hi_u32_b32 %0, -1, %0" : "=v"(Fp.lane)); Fp.tid = Fp.wave * 64 + Fp.lane

struct CvtRegs { float w[32]; f32x4 g0, g1; };
__device__ __forceinline__ void cvt_load(const float* W, const float* gain, int N, int item, int lane, CvtRegs& r) {
    const int nblk = N / 32, kb = item / nblk, nb = item % nblk, k0 = 64 * kb, n0 = 32 * nb;
    if (gain) { r.g0 = *(const GAS f32x4*)(gain + k0 + 8 * (lane & 7)); r.g1 = *(const GAS f32x4*)(gain + k0 + 8 * (lane & 7) + 4); } else { r.g0 = (f32x4){1.f, 1.f, 1.f, 1.f}; r.g1 = r.g0; }
#pragma unroll
    for (int i = 0; i < 32; ++i) r.w[i] = W[(size_t)(k0 + 2 * i + (lane >> 5)) * N + n0 + (lane & 31)];
}
template <int MODE> __device__ __forceinline__ void cvt_store(const CvtRegs& r, int K, int N, bf16* WT, LAS float* scr, int item, int lane) {
    const int nblk = N / 32, kb = item / nblk, nb = item % nblk, k0 = 64 * kb, n0 = 32 * nb;
#pragma unroll
    for (int i = 0; i < 32; ++i) { const int kk = 2 * i + (lane >> 5); scr[kk * 33 + (lane & 31)] = r.w[i]; }
    LDS_WAIT(); asm volatile("" ::: "memory");
    const int c = lane & 7;
    int r0 = n0; if (MODE == 1) { const int half = n0 / DFF, rr = n0 % DFF; r0 = (rr / 128) * 256 + half * 128 + (rr % 128); }
#pragma unroll
    for (int j = 0; j < 4; ++j) { const int n = (lane >> 3) + 8 * j; const LAS float* s = scr + (8 * c) * 33 + n;
        v4u o; o.x = pk2(s[0 * 33] * r.g0.x, s[1 * 33] * r.g0.y); o.y = pk2(s[2 * 33] * r.g0.z, s[3 * 33] * r.g0.w); o.z = pk2(s[4 * 33] * r.g1.x, s[5 * 33] * r.g1.y); o.w = pk2(s[6 * 33] * r.g1.z, s[7 * 33] * r.g1.w);
        *(GAS v4u*)(WT + (size_t)(r0 + n) * K + k0 + 8 * c) = o; }
    LDS_WAIT(); asm volatile("" ::: "memory");
}
template <int MODE> __device__ __forceinline__ void cvt_weight(const Frame& F, const float* W, const float* gain, int K, int N, bf16* WT) {
    LAS float* scr = (LAS float*)(F.lds + F.wave * 8704);
    const int gw = F.vcu * NWAVES + F.wave, NGW = F.G * NWAVES, nitems = (K / 64) * (N / 32);
    CvtRegs cur, nxt;
    if (gw < nitems) cvt_load(W, gain, N, gw, F.lane, cur);
    for (int it = gw; it < nitems; it += NGW) {
        const bool more = it + NGW < nitems;
        if (more) cvt_load(W, gain, N, it + NGW, F.lane, nxt);
        cvt_store<MODE>(cur, K, N, WT, scr, it, F.lane);
        if (more) { cur.g0 = nxt.g0; cur.g1 = nxt.g1;
#pragma unroll
            for (int i = 0; i < 32; ++i) cur.w[i] = nxt.w[i]; }
    }
}
__device__ __forceinline__ void prep_rows(const Frame& F, const float* xa, const float* xb, bf16* XN, float* rss) {
    const int gw = F.vcu * NWAVES + F.wave, NGW = F.G * NWAVES;
    f32x4 v[8], nx[8];
    if (gw < NTOK) { const GAS f32x4* xr = (const GAS f32x4*)((gw < NTOKP) ? xa + (size_t)gw * D : xb + (size_t)(gw - NTOKP) * D) + F.lane;
#pragma unroll
        for (int j = 0; j < 8; ++j) nx[j] = xr[64 * j]; }
    for (int m = gw; m < NTOK; m += NGW) {
#pragma unroll
        for (int j = 0; j < 8; ++j) v[j] = nx[j];
        { const int mn = (m + NGW < NTOK) ? m + NGW : m;
          const GAS f32x4* xr = (const GAS f32x4*)((mn < NTOKP) ? xa + (size_t)mn * D : xb + (size_t)(mn - NTOKP) * D) + F.lane;
#pragma unroll
          for (int j = 0; j < 8; ++j) nx[j] = xr[64 * j]; }
        float s = 0.f;
#pragma unroll
        for (int j = 0; j < 8; ++j) {
            const float a = bf_lo(f2bf(v[j].x)), b = bf_lo(f2bf(v[j].y)), c = bf_lo(f2bf(v[j].z)), d = bf_lo(f2bf(v[j].w)); s += (a * a + b * b) + (c * c + d * d); }
        s = wave_sum(s, F.lane);
        if (F.lane < 8) rss[(size_t)m * 8 + F.lane] = (F.lane == 0) ? s : 0.f;
        GAS v2u* o = (GAS v2u*)(XN + (size_t)m * D) + F.lane;
#pragma unroll
        for (int j = 0; j < 8; ++j) { v2u w; w.x = pk2(v[j].x, v[j].y); w.y = pk2(v[j].z, v[j].w); o[64 * j] = w; }
    }
}
__device__ __forceinline__ float rdlane(float v, int k) { return __builtin_bit_cast(float, __builtin_amdgcn_readlane(__builtin_bit_cast(int, v), k)); }
__device__ __forceinline__ void filter_mlp(const Frame& F, bf16* A3X, bf16* WOX) {
    const int gw = F.vcu * NWAVES + F.wave, NGW = F.G * NWAVES, lane = F.lane;
    for (int it = gw; it < 2 * HT_COLS; it += NGW) {
        const int j = it / HT_COLS, ip = it % HT_COLS;
        const int L = ip < LP ? LP : LS, i = ip < LP ? ip : ip - LP;
        const float* w1 = F.inp(8) + (size_t)j * 33 * 64; const float* b1 = F.inp(9) + j * 64; const float* w2 = F.inp(10) + (size_t)j * 64 * 64; const float* b2 = F.inp(11) + j * 64;
        const float* w3 = F.inp(12) + (size_t)j * 64 * 64; const float* b3 = F.inp(13) + j * 64; const float fr = F.inp(15)[j * 64 + lane];
        const float t = (float)i / (float)(L - 1);
        const float wang = (6.2831853071795864769f * (float)i) / (float)L;
        float feat = 0.f;
        if (lane == 0) feat = t;
        else if (lane <= 32) { const int b = (lane - 1) & 15; const float fb = (float)(1e-4 + (double)b * ((15.0 - 1e-4) / 15.0)); const float ang = wang * fb; feat = (lane <= 16) ? cosf(ang) : -sinf(ang); }
        float acc = b1[lane];
#pragma unroll
        for (int k = 0; k < 33; ++k) acc += rdlane(feat, k) * w1[k * 64 + lane];
        float a = sinf(fr * acc);
        acc = b2[lane];
#pragma unroll 16
        for (int k = 0; k < 64; ++k) acc += rdlane(a, k) * w2[k * 64 + lane];
        a = sinf(fr * acc);
        acc = b3[lane];
#pragma unroll 16
        for (int k = 0; k < 64; ++k) acc += rdlane(a, k) * w3[k * 64 + lane];
        a = sinf(fr * acc);
        const unsigned hi = f2bf(a); const float rem = a - __builtin_bit_cast(float, hi << 16); const unsigned lo = f2bf(rem);
        bf16* o = A3X + (size_t)it * 256;
        o[lane] = (bf16)hi; o[64 + lane] = (bf16)lo; o[128 + lane] = (bf16)hi; o[192 + lane] = 0;
    }
    for (int it = gw; it < 2 * HT_ROWS; it += NGW) {
        const int j = it / HT_ROWS, col = it % HT_ROWS;
        const float w = F.inp(14)[((size_t)j * 64 + lane) * HT_ROWS + col];
        const unsigned hi = f2bf(w); const float rem = w - __builtin_bit_cast(float, hi << 16); const unsigned lo = f2bf(rem);
        bf16* o = WOX + (size_t)it * 256;
        o[lane] = (bf16)hi; o[64 + lane] = (bf16)hi; o[128 + lane] = (bf16)lo; o[192 + lane] = 0;
    }
}
struct Raw8 { v4u c; unsigned p, n; };
__device__ __forceinline__ Raw8 ld8(const unsigned* row, int q, int ngrp) {
    Raw8 r; r.c = *(const v4u*)(row + 4 * q);
    const int qm = q > 0 ? 4 * q - 1 : 0, qp = (q + 1 < ngrp) ? 4 * q + 4 : 0;
    r.p = row[qm]; r.n = row[qp]; r.p = q > 0 ? r.p : 0u; r.n = (q + 1 < ngrp) ? r.n : 0u; return r;
}
__device__ __forceinline__ void sconv8(const Raw8& r, float c0, float c1, float c2, float cb, fc::cpx (&o)[4]) {
    float u[10]; u[0] = bf_hi(r.p); u[9] = bf_lo(r.n);
#pragma unroll
    for (int e = 0; e < 4; ++e) { u[1 + 2 * e] = bf_lo(r.c[e]); u[2 + 2 * e] = bf_hi(r.c[e]); }
#pragma unroll
    for (int i = 0; i < 4; ++i) o[i] = fc::cpx{c0 * u[2 * i] + c1 * u[2 * i + 1] + c2 * u[2 * i + 2] + cb, c0 * u[2 * i + 1] + c1 * u[2 * i + 2] + c2 * u[2 * i + 3] + cb};
}
#define CONV_SYNC asm volatile("s_waitcnt lgkmcnt(0)\n\ts_barrier" ::: "memory")
#define CONV_SYNC_FULL __syncthreads()
#define RFL(x) __builtin_bit_cast(float, __builtin_amdgcn_readfirstlane(__builtin_bit_cast(int, (x))))
#define SC_LOAD(pre, col) const float pre##0 = RFL(cw[col]), pre##1 = RFL(cw[NHY + (col)]), pre##2 = RFL(cw[2 * NHY + (col)]), pre##b = RFL(cbp[col])
template <int M, int NT> __device__ __forceinline__ void conv_part(const Frame& F, int hj, int c, int nseq, int tok0, int hcol0, const unsigned short* HT, bf16* UT, bf16* ZO, fc::f4* kb) {
    constexpr int L = M, NG = (L / 8) / NT, NH = 512 / NT;
    const int hh = (NH == 2) ? (F.wave >> 2) : 0;
    int tl = F.tid & (NT - 1);
    fc::lptr lds = (fc::lptr)F.lds + hh * fc::padi(8192);
    LAS float* red = (LAS float*)(F.lds + RED_OFF);
#pragma unroll 1
    for (int oi = 0; oi < 2 / NH; ++oi) {
        const int o = (NH == 2) ? hh : oi;
        const unsigned short* hf = HT + (size_t)((o * 2 + 0) * D + c) * HT_COLS + hcol0;
        const unsigned short* hb = HT + (size_t)((o * 2 + 1) * D + c) * HT_COLS + hcol0;
        float part = 0.f;
        OPAQUE_V(tl);
        v4u raw[2 * NG]; unsigned short top[NG];
#pragma unroll
        for (int it = 0; it < 2 * NG; ++it) { const int q = tl + NT * it;
            if (it < NG) raw[it] = ((const v4u*)hf)[q];
            else { const int qp = q - L / 8; raw[it] = ((const v4u*)hb)[L / 8 - 1 - qp]; top[it - NG] = hb[qp > 0 ? L - 8 * qp : 0]; } }
#pragma unroll
        for (int it = 0; it < 2 * NG; ++it) { const int q = tl + NT * it;
            float t[8];
#pragma unroll
            for (int e = 0; e < 4; ++e) { t[2 * e] = h2f((unsigned short)(raw[it][e] & 0xffffu)); t[2 * e + 1] = h2f((unsigned short)(raw[it][e] >> 16)); }
            fc::cpx o4[4];
            if (it < NG) { o4[0] = fc::cpx{t[0], t[1]}; o4[1] = fc::cpx{t[2], t[3]}; o4[2] = fc::cpx{t[4], t[5]}; o4[3] = fc::cpx{t[6], t[7]}; }
            else { const float tp = (q - L / 8 > 0) ? h2f(top[it - NG]) : 0.f; o4[0] = fc::cpx{tp, t[7]}; o4[1] = fc::cpx{t[6], t[5]}; o4[2] = fc::cpx{t[4], t[3]}; o4[3] = fc::cpx{t[2], t[1]}; }
#pragma unroll
            for (int i = 0; i < 4; ++i) { lds[fc::padi(4 * q) + i] = o4[i]; part += fabsf(o4[i].x) + fabsf(o4[i].y); } }
        part = wave_sum(part, F.lane);
        if (F.lane == 0) red[F.wave] = part;
        CONV_SYNC;
        float S = 0.f;
#pragma unroll
        for (int w = 0; w < 8 / NH; ++w) S += red[hh * 4 + w];
        FC_FWD(M, NT, lds, tl, CONV_SYNC);
        if (tl < L / 64) __builtin_amdgcn_global_load_lds((const unsigned*)(UT + (size_t)c * NTOK + tok0 + hh * L) + tl * 32, (LAS unsigned*)(F.lds + 139264) + F.wave * 64, 4, 0, 0);
        fc::filter_pass<M, NT>(lds, tl, 1.0f / (8.0f * (float)M * S), kb + o * KB_ORDER);
        CONV_SYNC_FULL;
    }
    const float* cw = F.inp(6) + (size_t)hj * 3 * NHY; const float* cbp = F.inp(7) + (size_t)hj * NHY; const float* sk = F.inp(16) + (size_t)hj * 2 * D;
    fc::f4* z1g = kb + 2 * KB_ORDER + hh * 2048;
#pragma unroll 1
    for (int s = 0; s < nseq; s += NH) {
        const int tok = tok0 + (s + hh) * L;
        const unsigned* uv = (const unsigned*)(UT + (size_t)c * NTOK + tok);
        const unsigned* ux1 = (const unsigned*)(UT + (size_t)(D + c) * NTOK + tok);
        const unsigned* ux2 = (const unsigned*)(UT + (size_t)(2 * D + c) * NTOK + tok);
        OPAQUE_V(tl);
        { SC_LOAD(cv, c);
          Raw8 rv[NG];
#pragma unroll
          for (int j = 0; j < NG; ++j) rv[j] = ld8(uv, tl + NT * j, L / 8);
#pragma unroll
          for (int j = 0; j < NG; ++j) { const int q = tl + NT * j; fc::cpx o4[4]; sconv8(rv[j], cv0, cv1, cv2, cvb, o4);
#pragma unroll
              for (int i = 0; i < 4; ++i) { lds[fc::padi(4 * q) + i] = o4[i]; } } }
        CONV_SYNC;
        { FC_FWD12Z(M, NT, lds, tl, CONV_SYNC);
          fc::KRegs<M, NT> kr; fc::k_prefetch<M, NT>(kb, tl, kr);
          FC_FWD3(M, NT, lds, tl, CONV_SYNC);
          fc::mult_pass<M, NT>(lds, tl, kr); }
        CONV_SYNC;
        OPAQUE_V(tl);
        { Raw8 rv[NG], ra[NG];
#pragma unroll
          for (int j = 0; j < NG; ++j) { rv[j] = ld8(uv, tl + NT * j, L / 8); ra[j] = ld8(ux1, tl + NT * j, L / 8); }
          FC_INVZ(M, NT, lds, tl, CONV_SYNC);
          SC_LOAD(cv, c); SC_LOAD(ca, D + c); const float skip0 = RFL(sk[c]);
#pragma unroll
          for (int j = 0; j < NG; ++j) { const int q = tl + NT * j; fc::cpx v4[4], a4[4], z[4]; sconv8(rv[j], cv0, cv1, cv2, cvb, v4); sconv8(ra[j], ca0, ca1, ca2, cab, a4);
#pragma unroll
              for (int i = 0; i < 4; ++i) { const fc::cpx y = lds[fc::padi(4 * q) + i]; z[i] = a4[i] * (y + skip0 * v4[i]); lds[fc::padi(4 * q) + i] = z[i]; }
              z1g[(j * NT + tl) * 2] = fc::f4{z[0].x, z[0].y, z[1].x, z[1].y}; z1g[(j * NT + tl) * 2 + 1] = fc::f4{z[2].x, z[2].y, z[3].x, z[3].y}; } }
        CONV_SYNC;
        { FC_FWD12Z(M, NT, lds, tl, CONV_SYNC);
          fc::KRegs<M, NT> kr; fc::k_prefetch<M, NT>(kb + KB_ORDER, tl, kr);
          FC_FWD3(M, NT, lds, tl, CONV_SYNC);
          fc::mult_pass<M, NT>(lds, tl, kr); }
        CONV_SYNC;
        OPAQUE_V(tl);
        { Raw8 rx[NG]; fc::f4 zp[NG][2];
#pragma unroll
          for (int j = 0; j < NG; ++j) { rx[j] = ld8(ux2, tl + NT * j, L / 8); zp[j][0] = z1g[(j * NT + tl) * 2]; zp[j][1] = z1g[(j * NT + tl) * 2 + 1]; }
          FC_INVZ(M, NT, lds, tl, CONV_SYNC);
          if (s + NH < nseq && tl < L / 64) __builtin_amdgcn_global_load_lds((const unsigned*)(UT + (size_t)c * NTOK + tok + NH * L) + tl * 32, (LAS unsigned*)(F.lds + 139264) + F.wave * 64, 4, 0, 0);
          SC_LOAD(cx, 2 * D + c); const float skip1 = RFL(sk[D + c]);
          v4u* zo = (v4u*)(ZO + (size_t)c * NTOK + tok);
#pragma unroll
          for (int j = 0; j < NG; ++j) { const int q = tl + NT * j; fc::cpx x4[4]; sconv8(rx[j], cx0, cx1, cx2, cxb, x4);
              unsigned w[4];
#pragma unroll
              for (int i = 0; i < 4; ++i) { const fc::cpx y = lds[fc::padi(4 * q) + i]; const fc::cpx z1 = fc::cpx{zp[j][i >> 1][2 * (i & 1)], zp[j][i >> 1][2 * (i & 1) + 1]}; const fc::cpx z2 = x4[i] * (y + skip1 * z1); w[i] = pk2(z2.x, z2.y); }
              zo[q] = v4u{w[0], w[1], w[2], w[3]}; } }
        CONV_SYNC;
    }
}
__device__ __forceinline__ void conv_phase(const Frame& F, int hj, const unsigned short* HT, bf16* UT, bf16* ZO, fc::f4* KB) {
    fc::f4* kb = KB + (size_t)F.bx * KB_BLOCK;
    for (int c = F.bx; c < D; c += F.G) {
        conv_part<LP, 256>(F, hj, c, NBP, 0, 0, HT, UT, ZO, kb);
        conv_part<LS, 512>(F, hj, c, 1, NTOKP, LP, HT, UT, ZO, kb);
    }
}
__device__ __forceinline__ void transpose_phase(const Frame& F, const bf16* ZT, bf16* Z) {
    constexpr int PIT = 68;
    LAS bf16* t = (LAS bf16*)(F.lds + F.wave * (64 * PIT * 2));
    const int gw = F.vcu * NWAVES + F.wave, NGW = F.G * NWAVES, lane = F.lane;
    constexpr int TN = NTOK / 64, NTILE = (D / 64) * TN;
    v4u w[8];
    if (gw < NTILE) { const int cb = gw / TN, tb = gw % TN;
#pragma unroll
        for (int i = 0; i < 8; ++i) w[i] = *(const GAS v4u*)(ZT + (size_t)(64 * cb + 8 * i + (lane >> 3)) * NTOK + 64 * tb + 8 * (lane & 7)); }
    for (int it = gw; it < NTILE; it += NGW) {
        const int cb = it / TN, tb = it % TN, c0 = 64 * cb, t0 = 64 * tb;
#pragma unroll
        for (int i = 0; i < 8; ++i) { const int ch = 8 * i + (lane >> 3), t8 = lane & 7;
            LAS v2u* p = (LAS v2u*)(t + ch * PIT + 8 * t8); p[0] = v2u{w[i].x, w[i].y}; p[1] = v2u{w[i].z, w[i].w}; }
        { const int in = (it + NGW < NTILE) ? it + NGW : it, cbn = in / TN, tbn = in % TN;
#pragma unroll
          for (int i = 0; i < 8; ++i) w[i] = *(const GAS v4u*)(ZT + (size_t)(64 * cbn + 8 * i + (lane >> 3)) * NTOK + 64 * tbn + 8 * (lane & 7)); }
        LDS_WAIT(); asm volatile("" ::: "memory");
#pragma unroll
        for (int i = 0; i < 8; ++i) { const int tk = 8 * i + (lane >> 3), c8 = lane & 7;
            const LAS bf16* s = t + (8 * c8) * PIT + tk;
            v4u o; o.x = (unsigned)s[0] | ((unsigned)s[PIT] << 16); o.y = (unsigned)s[2 * PIT] | ((unsigned)s[3 * PIT] << 16);
            o.z = (unsigned)s[4 * PIT] | ((unsigned)s[5 * PIT] << 16); o.w = (unsigned)s[6 * PIT] | ((unsigned)s[7 * PIT] << 16);
            *(GAS v4u*)(Z + (size_t)(t0 + tk) * D + c0 + 8 * c8) = o; }
        LDS_WAIT(); asm volatile("" ::: "memory");
    }
}
constexpr int ATT_BW = 321;
constexpr int ATT_KPITCH = 272, ATT_VPITCH = 320, ATT_K_OFF = 0, ATT_V_OFF = 128 * ATT_KPITCH, ATT_B_OFF = ATT_V_OFF + 128 * ATT_VPITCH, ATT_QPITCH = 272, ATT_STAGE = 32 * ATT_QPITCH, ATT_UNITS = (NTOK / 128) * NKV * 2;
__device__ __forceinline__ int t5_bucket(int rel) {
    const int n = rel < 0 ? -rel : rel; int b;
    if (n < 8) b = n; else if (n < 12) b = 8; else if (n < 16) b = 9; else if (n < 23) b = 10; else if (n < 32) b = 11; else if (n < 46) b = 12; else if (n < 64) b = 13; else if (n < 91) b = 14; else b = 15;
    return b + (rel > 0 ? 16 : 0);
}
typedef short v4i16_t __attribute__((ext_vector_type(4)));
__device__ __forceinline__ void attn_phase(const Frame& F, int aj, const bf16* QKV, bf16* O, const int dry = 0) {
    const int tid = F.tid, lane = F.lane, wave = F.wave, r32 = lane & 31, hi = lane >> 5;
    LAS unsigned char* lds = F.lds;
    LAS float* btab = (LAS float*)(lds + ATT_B_OFF);
    const float* qg = F.inp(20) + aj * HD; const float* kg = F.inp(21) + aj * HD; const float* sink = F.inp(22) + aj * NHEAD; const float* relb = F.inp(24);
    constexpr float LOG2E = 1.4426950408889634f;
    const int per = (ATT_UNITS + F.G - 1) / F.G;
    const int c16 = tid & 15, srow = tid >> 4;
    LAS float* qkt = (LAS float*)(lds + ATT_B_OFF + NHEAD * ATT_BW * 4);
    if (tid < HD) qkt[tid] = qg[tid] * kg[tid] * (0.08838834764831845f * 1.4426950408889634f);
    const int vtr = (4 * hi + ((lane >> 2) & 3)) * ATT_VPITCH + (16 * ((lane >> 4) & 1) + 4 * (lane & 3)) * 2;
    for (int idx = tid; idx < NHEAD * ATT_BW; idx += 512) { const int hh = idx / ATT_BW, rel = idx % ATT_BW - 160; btab[idx] = (rel >= -128 && rel <= 128) ? relb[t5_bucket(rel) * NHEAD + hh] * LOG2E : -1e30f; }
    __syncthreads();
    LAS unsigned char* stg = lds + wave * ATT_STAGE;
    const int st_row = lane >> 4, st_c16 = lane & 15;
    auto first_src = [&](int uu) -> const bf16* {
        const int g_ = (uu >> 1) & 3, blk_ = uu >> 3; int tokS_, n_;
        if (blk_ < 256) { tokS_ = (blk_ >> 6) * LP; n_ = blk_ & 63; } else { tokS_ = NTOKP; n_ = blk_ - 256; }
        return QKV + (size_t)(tokS_ + (n_ + ((n_ == 0) ? 1 : 0) - 1) * 128 + srow) * NQKV + 2048 + g_ * HD + 8 * c16;
    };
    const int qo = 32 * ((0x12032130u >> (4 * wave)) & 3);
    auto q_src = [&](int uu) -> const bf16* {
        const int hp_ = uu & 1, g_ = (uu >> 1) & 3, blk_ = uu >> 3; int tokS_, n_;
        if (blk_ < 256) { tokS_ = (blk_ >> 6) * LP; n_ = blk_ & 63; } else { tokS_ = NTOKP; n_ = blk_ - 256; }
        return QKV + (size_t)(tokS_ + n_ * 128 + qo + st_row) * NQKV + (4 * g_ + 2 * hp_ + (wave >> 2)) * HD + 8 * st_c16;
    };
    v4u qv[8];
    if (F.vcu * per < ATT_UNITS) { const bf16* qsrc = q_src(F.vcu * per);
#pragma unroll
        for (int i = 0; i < 8; ++i) qv[i] = *(const GAS v4u*)(qsrc + (size_t)(4 * i) * NQKV); }
    v4u kr[4], vr[4];
    if (F.vcu * per < ATT_UNITS) { const bf16* src = first_src(F.vcu * per);
#pragma unroll
        for (int p = 0; p < 4; ++p) { kr[p] = *(const GAS v4u*)(src + (size_t)(32 * p) * NQKV); vr[p] = *(const GAS v4u*)(src + (size_t)(32 * p) * NQKV + 512); } }
#pragma unroll 1
    for (int ui = 0; ui < per; ++ui) {
        const int u = F.vcu * per + ui;
        if (u >= ATT_UNITS) break;
        const int hp = u & 1, g = (u >> 1) & 3, blk = u >> 3;
        int tokS, L, n;
        if (blk < 256) { tokS = (blk >> 6) * LP; L = LP; n = blk & 63; } else { tokS = NTOKP; L = LS; n = blk - 256; }
        const int head = 4 * g + 2 * hp + (wave >> 2);
        const int ck0 = (n == 0) ? 1 : 0, ck1 = (n == L / 128 - 1) ? 1 : 2;
        bf16x8 qf[8];
        {
#pragma unroll
            for (int i = 0; i < 8; ++i) *(LAS v4u*)(stg + (st_row + 4 * i) * ATT_QPITCH + 16 * st_c16) = qv[i];
            LDS_WAIT(); asm volatile("" ::: "memory");
            v4u raw[8]; float ss = 0.f;
#pragma unroll
            for (int d0 = 0; d0 < 8; ++d0) { raw[d0] = *(const LAS v4u*)(stg + r32 * ATT_QPITCH + 32 * d0 + 16 * hi);
#pragma unroll
                for (int e = 0; e < 4; ++e) { const float a = bf_lo(raw[d0][e]), b = bf_hi(raw[d0][e]); ss += a * a + b * b; } }
            ss = sum_halves(ss);
            const float sc = __builtin_amdgcn_rsqf(ss * (1.0f / HD) + EPS);
            int hq = hi; OPAQUE_V(hq);
#pragma unroll
            for (int d0 = 0; d0 < 8; ++d0) { const f32x4 g0 = *(const LAS f32x4*)(qkt + 16 * d0 + 8 * hq), g1 = *(const LAS f32x4*)(qkt + 16 * d0 + 8 * hq + 4);
                v4u w;
                w.x = pk2(bf_lo(raw[d0].x) * sc * g0.x, bf_hi(raw[d0].x) * sc * g0.y); w.y = pk2(bf_lo(raw[d0].y) * sc * g0.z, bf_hi(raw[d0].y) * sc * g0.w);
                w.z = pk2(bf_lo(raw[d0].z) * sc * g1.x, bf_hi(raw[d0].z) * sc * g1.y); w.w = pk2(bf_lo(raw[d0].w) * sc * g1.z, bf_hi(raw[d0].w) * sc * g1.w);
                qf[d0] = __builtin_bit_cast(bf16x8, w); }
        }
        float mrun = sink[head] * LOG2E, lrun = (hi == 0) ? 1.0f : 0.0f;
        f32x16 negm;
#pragma unroll
        for (int e = 0; e < 16; ++e) negm[e] = -mrun;
        f32x16 oacc[4];
#pragma unroll
        for (int dt = 0; dt < 4; ++dt)
#pragma unroll
            for (int e = 0; e < 16; ++e) oacc[dt][e] = 0.f;
#pragma unroll 1
        for (int ck = ck0; ck <= (dry >= 3 ? ck0 - 1 : ck1); ++ck) {
            __syncthreads();
#pragma unroll
            for (int p = 0; p < 4; ++p) { const int row = srow + 32 * p;
                float ss = 0.f;
#pragma unroll
                for (int e = 0; e < 4; ++e) { const float a = bf_lo(kr[p][e]), b = bf_hi(kr[p][e]); ss += a * a + b * b; }
                ss = sum16(ss);
                const float rs = __builtin_amdgcn_rsqf(ss * (1.0f / HD) + EPS);
                v4u w;
                w.x = pk2(bf_lo(kr[p].x) * rs, bf_hi(kr[p].x) * rs); w.y = pk2(bf_lo(kr[p].y) * rs, bf_hi(kr[p].y) * rs);
                w.z = pk2(bf_lo(kr[p].z) * rs, bf_hi(kr[p].z) * rs); w.w = pk2(bf_lo(kr[p].w) * rs, bf_hi(kr[p].w) * rs);
                *(LAS v4u*)(lds + ATT_K_OFF + row * ATT_KPITCH + 16 * c16) = w;
                *(LAS v4u*)(lds + ATT_V_OFF + row * ATT_VPITCH + 16 * c16) = vr[p]; }
            __syncthreads();
            if (ck < ck1 || (ui + 1 < per && u + 1 < ATT_UNITS)) {
                const bf16* src = (ck < ck1) ? QKV + (size_t)(tokS + (n + ck) * 128 + srow) * NQKV + 2048 + g * HD + 8 * c16 : first_src(u + 1);
#pragma unroll
                for (int p = 0; p < 4; ++p) { kr[p] = *(const GAS v4u*)(src + (size_t)(32 * p) * NQKV); vr[p] = *(const GAS v4u*)(src + (size_t)(32 * p) * NQKV + 512); } }
#pragma unroll 1
            for (int kt = 0; kt < (dry >= 2 ? 0 : 4); ++kt) {
                const int T = 4 * ck + kt;
                if (T < (qo >> 5) || T > (qo >> 5) + 8) continue;
                const int relb0 = 32 * T + 4 * hi - 128 - (qo + r32);
                const LAS float* bt = btab + head * ATT_BW + 160;
                f32x16 sacc, sacc2;
                { unsigned bpa = (unsigned)(unsigned long long)(bt + relb0); OPAQUE_V(bpa); const LAS float* bp = (const LAS float*)(unsigned long long)bpa;
#pragma unroll
                  for (int e = 0; e < 16; ++e) sacc[e] = bp[(e & 3) + 8 * (e >> 2)]; }
                const LAS unsigned char* kp = lds + ATT_K_OFF + (32 * kt + r32) * ATT_KPITCH + 16 * hi;
                bf16x8 kfr[8];
                asm volatile("ds_read_b128 %0, %8\n\tds_read_b128 %1, %8 offset:32\n\tds_read_b128 %2, %8 offset:64\n\tds_read_b128 %3, %8 offset:96\n\t"
                             "ds_read_b128 %4, %8 offset:128\n\tds_read_b128 %5, %8 offset:160\n\tds_read_b128 %6, %8 offset:192\n\tds_read_b128 %7, %8 offset:224"
                             : "=&v"(kfr[0]), "=&v"(kfr[1]), "=&v"(kfr[2]), "=&v"(kfr[3]), "=&v"(kfr[4]), "=&v"(kfr[5]), "=&v"(kfr[6]), "=&v"(kfr[7]) : "v"(kp) : "memory");
                asm volatile("s_waitcnt lgkmcnt(0)" : "+v"(kfr[0]), "+v"(kfr[1]), "+v"(kfr[2]), "+v"(kfr[3]), "+v"(kfr[4]), "+v"(kfr[5]), "+v"(kfr[6]), "+v"(kfr[7]));
#pragma unroll
                for (int d0 = 0; d0 < 8; d0 += 2) { sacc2 = __builtin_amdgcn_mfma_f32_32x32x16_bf16(kfr[d0 + 1], qf[d0 + 1], d0 == 0 ? negm : sacc2, 0, 0, 0); sacc = __builtin_amdgcn_mfma_f32_32x32x16_bf16(kfr[d0], qf[d0], sacc, 0, 0, 0); }
#pragma unroll
                for (int e = 0; e < 16; ++e) sacc[e] += sacc2[e];
                float mx = -1e30f;
#pragma unroll
                for (int e = 0; e < 16; ++e) mx = fmaxf(mx, sacc[e]);
                mx = max_halves(mx);
                if (__builtin_amdgcn_ballot_w64(mx > 8.0f) != 0ull) {
                    const float dm = fmaxf(mx, 0.f), alpha = __builtin_amdgcn_exp2f(-dm);
                    mrun += dm; lrun *= alpha;
#pragma unroll
                    for (int e = 0; e < 16; ++e) { sacc[e] -= dm; negm[e] = -mrun; }
#pragma unroll
                    for (int dt = 0; dt < 4; ++dt)
#pragma unroll
                        for (int e = 0; e < 16; ++e) oacc[dt][e] *= alpha; }
                float ps = 0.f;
#pragma unroll
                for (int e = 0; e < 16; ++e) { const float p = __builtin_amdgcn_exp2f(sacc[e]); sacc[e] = p; ps += p; }
                lrun += ps;
                bf16x8 pf[2];
#pragma unroll
                for (int s = 0; s < 2; ++s) { v4u w; w.x = pk2(sacc[8 * s + 0], sacc[8 * s + 1]); w.y = pk2(sacc[8 * s + 2], sacc[8 * s + 3]); w.z = pk2(sacc[8 * s + 4], sacc[8 * s + 5]); w.w = pk2(sacc[8 * s + 6], sacc[8 * s + 7]);
                    pf[s] = __builtin_bit_cast(bf16x8, w); }
#pragma unroll
                for (int s = 0; s < 2; ++s)
                { v4i16_t a0[4], a1[4];
#pragma unroll
                    for (int dt = 0; dt < 4; ++dt) { const LAS unsigned char* vp = lds + ATT_V_OFF + (32 * kt) * ATT_VPITCH + 64 * dt + vtr;
                        a0[dt] = __builtin_amdgcn_ds_read_tr16_b64_v4i16((LAS v4i16_t*)(vp + (16 * s) * ATT_VPITCH));
                        a1[dt] = __builtin_amdgcn_ds_read_tr16_b64_v4i16((LAS v4i16_t*)(vp + (16 * s + 8) * ATT_VPITCH)); }
#pragma unroll
                    for (int dt = 0; dt < 4; ++dt) { const bf16x8 af = (bf16x8){a0[dt][0], a0[dt][1], a0[dt][2], a0[dt][3], a1[dt][0], a1[dt][1], a1[dt][2], a1[dt][3]};
                        oacc[dt] = __builtin_amdgcn_mfma_f32_32x32x16_bf16(af, pf[s], oacc[dt], 0, 0, 0); } }
            }
        }
        const float ltot = sum_halves(lrun), inv = __builtin_amdgcn_rcpf(ltot);
        { const bf16* qsrc = q_src((ui + 1 < per && u + 1 < ATT_UNITS) ? u + 1 : u);
#pragma unroll
            for (int i = 0; i < 8; ++i) qv[i] = *(const GAS v4u*)(qsrc + (size_t)(4 * i) * NQKV); }
        __syncthreads();
#pragma unroll
        for (int dt = 0; dt < 4; ++dt)
#pragma unroll
            for (int q4 = 0; q4 < 4; ++q4) { v2u w; w.x = pk2(oacc[dt][4 * q4] * inv, oacc[dt][4 * q4 + 1] * inv); w.y = pk2(oacc[dt][4 * q4 + 2] * inv, oacc[dt][4 * q4 + 3] * inv);
                *(LAS v2u*)(stg + r32 * ATT_QPITCH + (32 * dt + 8 * q4 + 4 * hi) * 2) = w; }
        LDS_WAIT(); asm volatile("" ::: "memory");
        { bf16* odst = O + (size_t)(tokS + n * 128 + qo + st_row) * D + head * HD + 8 * st_c16;
#pragma unroll
          for (int i = 0; i < 8; ++i) { const v4u w = *(const LAS v4u*)(stg + (st_row + 4 * i) * ATT_QPITCH + 16 * st_c16); *(GAS v4u*)(odst + (size_t)(4 * i) * D) = w; } }
    }
}

__global__ void __launch_bounds__(NWAVES * 64, 2) trunk_fwd(Args args) {
    extern __shared__ __attribute__((aligned(16))) unsigned char lds_raw[];
    Frame F;
    F.lds = (LAS unsigned char*)lds_raw;
    F.tid = threadIdx.x; F.lane = F.tid & 63; F.wave = __builtin_amdgcn_readfirstlane(F.tid >> 6);
    F.G = gridDim.x; F.bx = blockIdx.x; { const int bx = blockIdx.x; F.vcu = (F.G % 8 == 0) ? (bx % 8) * (F.G / 8) + bx / 8 : bx; }
    volatile LAS unsigned* MISC = (volatile LAS unsigned*)(F.lds + MISC_OFF);
    if (F.tid < 64) MISC[F.tid] = 0u;
    __syncthreads();
    if (F.tid < 27) { const unsigned long long v = (unsigned long long)args.in[F.tid]; MISC[64 + 2 * F.tid] = (unsigned)v; MISC[65 + 2 * F.tid] = (unsigned)(v >> 32); }
    if (F.tid == 27) { const unsigned long long v = (unsigned long long)args.out; MISC[64 + 54] = (unsigned)v; MISC[64 + 55] = (unsigned)(v >> 32); }
    if (F.tid == 28) { const unsigned long long v = (unsigned long long)args.ws; MISC[64 + 56] = (unsigned)v; MISC[64 + 57] = (unsigned)(v >> 32); }
    __syncthreads();
    XcdBarrier bar; bar.bar = (unsigned*)(args.ws + WS_CTL) + CW_BAR; bar.x = 0; bar.st = nullptr;
    if (!MK_PER_PHASE) bar = xcd_barrier_post((unsigned*)(args.ws + WS_CTL) + CW_BAR, MISC + 8);
    const int lo = args.ph_lo, hi = args.ph_hi;
#if defined(PROBE_REP) || defined(PROBE_ATT) || defined(PROBE_UB)
    const int dry = args.dry;
#else
    constexpr int dry = 0;
#endif
#define IN(k) (lo <= (k) && (k) < hi)
#define SEAM(k) do { if (IN(k) && IN((k) + 1)) xcd_barrier(bar); } while (0)
#define WSB(off) ((bf16*)(Fp.wsp() + (off)))

#define RSS(n) ((float*)(Fp.wsp() + WS_RSS) + (size_t)((n) & 1) * NTOK * 8)
#define EPART ((pg8_las_f*)(Fp.lds + 131072))
#define ETAB ((pg8_las_f*)(Fp.lds + 131072 + 4096))
#define ERAW ((pg8_las_f*)(Fp.lds + 131072 + 5120))
#ifdef PROBE_UB
    if (IN(0) && dry >= 2) { PH_FRAME(Fp);
        typedef float f2 __attribute__((ext_vector_type(2)));
        f2 acc[16]; float s = (float)Fp.tid * 1e-9f;
#pragma unroll
        for (int i = 0; i < 16; ++i) acc[i] = (f2){s + i, s - i};
        const f2 m = (f2){0.999f, 0.998f}, ad = (f2){1e-3f, 2e-3f};
#pragma unroll 1
        for (int it = 0; it < 16384; ++it) {
#pragma unroll
            for (int i = 0; i < 16; ++i) {
                if (dry == 2) asm volatile("v_pk_fma_f32 %0, %0, %1, %2" : "+v"(acc[i]) : "v"(m), "v"(ad));
                else if (dry == 3) asm volatile("v_fma_f32 %0, %0, %1, %2" : "+v"(acc[i].x) : "v"(m.x), "v"(ad.x));
                else asm volatile("v_pk_add_f32 %0, %0, %1" : "+v"(acc[i]) : "v"(ad));
            }
        }
        float t = 0.f;
#pragma unroll
        for (int i = 0; i < 16; ++i) t += acc[i].x + acc[i].y;
        if (t != t) ((float*)WSB(WS_KB))[Fp.tid] = t;
    } else
#endif
    if (IN(0)) { PH_FRAME(Fp);
        filter_mlp(Fp, WSB(WS_A3X), WSB(WS_WOX));
        cvt_weight<0>(Fp, Fp.inp(4), Fp.inp(2), D, NHY, WSB(WS_WMA));
        cvt_weight<0>(Fp, Fp.inp(17), nullptr, D, D, WSB(WS_WMB));
        prep_rows(Fp, Fp.inp(0), Fp.inp(1), WSB(WS_XN), RSS(0));
    }
    SEAM(0);
#pragma unroll 1
    for (int p = 0; p < 2; ++p) {
        const int base = 1 + 11 * p;
        {
            const int layer = 2 * p;
            if (IN(base + 0)) { PH_FRAME(Fp);
                { pg8::Gemm g{WSB(WS_WMA), WSB(WS_XN), NHY, NTOK, D}; pg8::StaticOrder S; S.init(NHY, NTOK, Fp.G, Fp.bx);
                  pg8::EpiBf16 E{WSB(WS_BIG), NTOK, Fp.inp(5) + (size_t)p * NHY, nullptr, RSS(2 * layer), ETAB, ERAW};
                  pg8::gemm_phase<pg8::EpiBf16, pg8::StaticOrder, true, true>(Fp.lds, g, S, E, Fp.wave); }
                { int kt = 256; OPAQUE_S(kt);
                  pg8::Gemm g{WSB(WS_WOX) + (size_t)p * HT_ROWS * 256, WSB(WS_A3X) + (size_t)p * HT_COLS * 256, HT_ROWS, HT_COLS, kt}; pg8::StaticOrder S; S.init(HT_ROWS, HT_COLS, Fp.G, Fp.bx);
                  pg8::EpiTaps E{(unsigned short*)WSB(WS_HT), HT_COLS};
                  pg8::gemm_phase<pg8::EpiTaps, pg8::StaticOrder, true, true>(Fp.lds, g, S, E, Fp.wave); }
            }
            SEAM(base + 0);
            if (IN(base + 1)) { PH_FRAME(Fp);
                cvt_weight<1>(Fp, Fp.inp(25) + (size_t)layer * D * NGU, Fp.inp(3) + layer * D, D, NGU, WSB(WS_WGU));
                cvt_weight<0>(Fp, Fp.inp(26) + (size_t)layer * DFF * D, nullptr, DFF, D, WSB(WS_WDN));
                __syncthreads();
                conv_phase(Fp, p, (unsigned short*)WSB(WS_HT), WSB(WS_BIG), dry ? WSB(WS_XN) : WSB(WS_BIG), (fc::f4*)WSB(WS_KB));
            }
            SEAM(base + 1);
            if (IN(base + 2)) { PH_FRAME(Fp); transpose_phase(Fp, WSB(WS_BIG), WSB(WS_HT)); }
            SEAM(base + 2);
            if (IN(base + 3)) { PH_FRAME(Fp);
                pg8::Gemm g{WSB(WS_HT), WSB(WS_WMB), NTOK, D, D}; pg8::StaticOrder S; S.init(NTOK, D, Fp.G, Fp.bx);
                pg8::EpiRes16 E{WSB(WS_XN), D, Fp.inp(18) + (size_t)p * D, nullptr, RSS(2 * layer + 1), EPART};
                pg8::gemm_phase<pg8::EpiRes16, pg8::StaticOrder, true, true>(Fp.lds, g, S, E, Fp.wave);
            }
            SEAM(base + 3);
            if (IN(base + 4)) { PH_FRAME(Fp);
                cvt_weight<0>(Fp, Fp.inp(19) + (size_t)p * D * NQKV, Fp.inp(2) + (layer + 1) * D, D, NQKV, WSB(WS_WMA));
                cvt_weight<0>(Fp, Fp.inp(23) + (size_t)p * D * D, nullptr, D, D, WSB(WS_WMB));
                __syncthreads();
                pg8::Gemm g{WSB(WS_XN), WSB(WS_WGU), NTOK, NGU, D}; pg8::StaticOrder S; S.init(NTOK, NGU, Fp.G, Fp.bx);
                pg8::EpiSwiGLU E{WSB(WS_BIG), DFF, RSS(2 * layer + 1), ETAB, ERAW};
                pg8::gemm_phase<pg8::EpiSwiGLU, pg8::StaticOrder, true, true>(Fp.lds, g, S, E, Fp.wave);
            }
            SEAM(base + 4);
            if (IN(base + 5)) { PH_FRAME(Fp);
                pg8::Gemm g{WSB(WS_BIG), WSB(WS_WDN), NTOK, D, DFF}; pg8::StaticOrder S; S.init(NTOK, D, Fp.G, Fp.bx);
                pg8::EpiRes16 E{WSB(WS_XN), D, nullptr, nullptr, RSS(2 * layer + 2), EPART};
                pg8::gemm_phase<pg8::EpiRes16, pg8::StaticOrder, true, true>(Fp.lds, g, S, E, Fp.wave);
            }
            SEAM(base + 5);
        }
        {
            const int layer = 2 * p + 1;
            if (IN(base + 6)) { PH_FRAME(Fp);
                pg8::Gemm g{WSB(WS_XN), WSB(WS_WMA), NTOK, NQKV, D}; pg8::StaticOrder S; S.init(NTOK, NQKV, Fp.G, Fp.bx);
                pg8::EpiBf16 E{WSB(WS_BIG), NQKV, nullptr, RSS(2 * layer), nullptr, ETAB, ERAW};
                pg8::gemm_phase<pg8::EpiBf16, pg8::StaticOrder, true, true>(Fp.lds, g, S, E, Fp.wave);
            }
            SEAM(base + 6);
            if (IN(base + 7)) { PH_FRAME(Fp);
                cvt_weight<1>(Fp, Fp.inp(25) + (size_t)layer * D * NGU, Fp.inp(3) + layer * D, D, NGU, WSB(WS_WGU));
                cvt_weight<0>(Fp, Fp.inp(26) + (size_t)layer * DFF * D, nullptr, DFF, D, WSB(WS_WDN));
                __syncthreads();
                attn_phase(Fp, p, WSB(WS_BIG), WSB(WS_HT), dry);
            }
            SEAM(base + 7);
            if (IN(base + 8)) { PH_FRAME(Fp);
                pg8::Gemm g{WSB(WS_HT), WSB(WS_WMB), NTOK, D, D}; pg8::StaticOrder S; S.init(NTOK, D, Fp.G, Fp.bx);
                pg8::EpiRes16 E{WSB(WS_XN), D, nullptr, nullptr, RSS(2 * layer + 1), EPART};
                pg8::gemm_phase<pg8::EpiRes16, pg8::StaticOrder, true, true>(Fp.lds, g, S, E, Fp.wave);
            }
            SEAM(base + 8);
            if (IN(base + 9)) { PH_FRAME(Fp);
                if (p == 0) { cvt_weight<0>(Fp, Fp.inp(4) + (size_t)D * NHY, Fp.inp(2) + (layer + 1) * D, D, NHY, WSB(WS_WMA));
                              cvt_weight<0>(Fp, Fp.inp(17) + (size_t)D * D, nullptr, D, D, WSB(WS_WMB)); }
                __syncthreads();
                pg8::Gemm g{WSB(WS_XN), WSB(WS_WGU), NTOK, NGU, D}; pg8::StaticOrder S; S.init(NTOK, NGU, Fp.G, Fp.bx);
                pg8::EpiSwiGLU E{WSB(WS_BIG), DFF, RSS(2 * layer + 1), ETAB, ERAW};
                pg8::gemm_phase<pg8::EpiSwiGLU, pg8::StaticOrder, true, true>(Fp.lds, g, S, E, Fp.wave);
            }
            SEAM(base + 9);
            if (IN(base + 10)) { PH_FRAME(Fp);
                pg8::Gemm g{WSB(WS_BIG), WSB(WS_WDN), NTOK, D, DFF}; pg8::StaticOrder S; S.init(NTOK, D, Fp.G, Fp.bx);
                pg8::EpiRes16 E{WSB(WS_XN), D, nullptr, p == 0 ? (float*)nullptr : Fp.outp(), p == 0 ? RSS(2 * layer + 2) : (float*)nullptr, EPART};
                pg8::gemm_phase<pg8::EpiRes16, pg8::StaticOrder, true, true>(Fp.lds, g, S, E, Fp.wave);
            }
            SEAM(base + 10);
        }
    }
#undef RSS
#undef EPART
#undef ETAB
#undef ERAW
#undef IN
#undef SEAM
#undef WSB
}

extern "C" void kernel_launch(void* const* d_in, const int* in_sizes, int n_in, void* d_out, int out_size, void* d_ws, size_t ws_size, hipStream_t stream) {
    static int grid = 0;
    if (grid == 0) {
        if (n_in != 27 || out_size != NTOK * D || ws_size < WS_END) { fprintf(stderr, "kernel_launch: unexpected shapes: n_in %d out %d ws %zu (need %zu)\n", n_in, out_size, ws_size, (size_t)WS_END); grid = -1; return; }
        int dev = 0, cus = 0, per_cu = 0;
        if (hipGetDevice(&dev) != hipSuccess || hipDeviceGetAttribute(&cus, hipDeviceAttributeMultiprocessorCount, dev) != hipSuccess) { grid = -1; return; }
        if (hipFuncSetAttribute((const void*)trunk_fwd, hipFuncAttributeMaxDynamicSharedMemorySize, LDS_BYTES) != hipSuccess) { fprintf(stderr, "kernel_launch: hipFuncSetAttribute failed\n"); grid = -1; return; }
        if (hipOccupancyMaxActiveBlocksPerMultiprocessor(&per_cu, (const void*)trunk_fwd, NWAVES * 64, LDS_BYTES) != hipSuccess || per_cu < 1) fprintf(stderr, "kernel_launch: occupancy query reports %d\n", per_cu);
        (void)hipGetLastError();
        grid = cus;
        if (grid != 256) fprintf(stderr, "kernel_launch: %d CUs (built for 256)\n", grid);
    }
    if (grid < 0) return;
    if (hipMemsetAsync((char*)d_ws + WS_CTL, 0, CTL_ZERO_BYTES, stream) != hipSuccess) return;
    Args a{};
    for (int i = 0; i < 27; ++i) a.in[i] = (const float*)d_in[i];
    a.out = (float*)d_out; a.ws = (unsigned char*)d_ws;
#if MK_PER_PHASE
    for (int ph = 0; ph < NPHASE; ++ph) {
        a.ph_lo = ph; a.ph_hi = ph + 1;
#ifdef PROBE_REP
        { const int kk = ph == 0 ? -1 : (ph - 1) % 11;
          const int cls = (ph == 0 || kk == 2) ? 64 : (kk == 0 || kk == 6) ? 1 : (kk == 1) ? 2 : (kk == 7) ? 4 : (kk == 4 || kk == 9) ? 8 : (kk == 3 || kk == 8) ? 16 : 32;
#ifdef PROBE_ATT
          if (kk == 7) { a.dry = PROBE_ATT; hipLaunchKernelGGL(trunk_fwd, dim3(grid), dim3(NWAVES * 64), LDS_BYTES, stream, a); a.dry = 0; }
#endif
#ifdef PROBE_UB
          if (ph == 0) { a.dry = PROBE_UB; hipLaunchKernelGGL(trunk_fwd, dim3(grid), dim3(NWAVES * 64), LDS_BYTES, stream, a); a.dry = 0; }
#endif
          if (PROBE_REP & cls) { a.dry = 1; hipLaunchKernelGGL(trunk_fwd, dim3(grid), dim3(NWAVES * 64), LDS_BYTES, stream, a); a.dry = 0; } }
#endif
        hipLaunchKernelGGL(trunk_fwd, dim3(grid), dim3(NWAVES * 64), LDS_BYTES, stream, a);
    }
#else
    a.ph_lo = 0; a.ph_hi = NPHASE;
    hipLaunchKernelGGL(trunk_fwd, dim3(grid), dim3(NWAVES * 64), LDS_BYTES, stream, a);
#endif
    const hipError_t le = hipPeekAtLastError();
    if (le != hipSuccess) fprintf(stderr, "kernel_launch: launch failed: %s\n", hipGetErrorName(le));
}
```

```cpp
#include <hip/hip_runtime.h>
#include <cstdio>
#include <cstdint>
#define FC_ASM_CMUL
#define FC_ASM_CMULK
namespace pg8 {
#define PG8_LAS __attribute__((address_space(3)))
typedef unsigned short bf16_t;
typedef short bf16x8 __attribute__((ext_vector_type(8)));
typedef float f32x4 __attribute__((ext_vector_type(4)));
typedef unsigned u32x4 __attribute__((ext_vector_type(4)));
constexpr int BM = 256, BK = 64, HALF = 128, HTB = HALF * BK * 2  , STAGE_BYTES = 8 * HTB, NXCD = 8, WGM = 4;

__host__ __device__ __forceinline__ int lds_byte(int r, int c) { const int st = (r >> 4) * 2 + (c >> 5), rr = r & 15, cc = c & 31, ob = rr * 64 + cc * 2; return st * 1024 + (ob ^ (((ob >> 9) & 1) << 5)); }
__host__ __device__ __forceinline__ void stage_rc(int b, int& R, int& C) { const int st = b / 1024, sb = b % 1024, swz = sb ^ (((sb >> 9) & 1) << 5); R = (st >> 1) * 16 + swz / 64; C = (st & 1) * 32 + (swz % 64) / 2; }
__host__ __device__ __forceinline__ int perm32(int rho) { const int n = rho >> 4, i = rho & 15; return 8 * (i >> 2) + 4 * n + (i & 3); }

struct Unit { int pm, pn; };
struct Gemm { const bf16_t* A; const bf16_t* Bt; int M, N, K; };

struct StaticOrder {
    int nM, nN, nwg, G, c;
    __host__ __device__ void init(int M, int N, int G_, int c_) { nM = M / BM; nN = N / BM; nwg = nM * nN; G = G_; c = c_; }
    __host__ __device__ bool next(int i, Unit& u) const {
        const long L = (long)i * G + c; if (L >= nwg) return false;
        int wgid = (int)L; { const int q = nwg / NXCD, r = nwg % NXCD, xcd = wgid % NXCD, off = wgid / NXCD; wgid = (xcd < r ? xcd * (q + 1) : r * (q + 1) + (xcd - r) * q) + off; }
        const int nig = WGM * nN, gid = wgid / nig, fm = gid * WGM, gsz = (nM - fm) < WGM ? (nM - fm) : WGM;
        u.pm = fm + ((wgid % nig) % gsz); u.pn = (wgid % nig) / gsz; return true;
    }
    __device__ __forceinline__ void a_ready(const Unit&) const {}
    __device__ __forceinline__ void done(const Unit&) const {}
};

__device__ __forceinline__ unsigned cvt_pk_bf16(float lo, float hi) { unsigned r; asm volatile("v_cvt_pk_bf16_f32 %0, %1, %2" : "=v"(r) : "v"(lo), "v"(hi)); return r; }
typedef float f32x2 __attribute__((ext_vector_type(2)));
__device__ __forceinline__ unsigned cvt_pk_f16(float lo, float hi) { typedef _Float16 h2_t __attribute__((ext_vector_type(2))); h2_t v; v.x = (_Float16)lo; v.y = (_Float16)hi; return __builtin_bit_cast(unsigned, v); }
__device__ __forceinline__ float rstd_of(float ss) { return __builtin_amdgcn_rsqf(ss * (1.0f / 2048.0f) + 1e-6f); }
__device__ __forceinline__ float rstd8(const float* rss, int t) { const f32x4 a = *(const f32x4*)(rss + (size_t)t * 8), b = *(const f32x4*)(rss + (size_t)t * 8 + 4); return rstd_of(((a[0] + a[1]) + (a[2] + a[3])) + ((b[0] + b[1]) + (b[2] + b[3]))); }
__device__ __forceinline__ void rss_prefetch(PG8_LAS float* raw, const float* rss, int tok0, int wid, int lane) {
    __builtin_amdgcn_global_load_lds((const unsigned*)(rss + (size_t)tok0 * 8 + (wid * 64 + lane) * 4), (PG8_LAS unsigned*)(raw + wid * 256), 16, 0, 0);
}
__device__ __forceinline__ void rstd_table(PG8_LAS float* tab, PG8_LAS const float* raw, int wr, int wc, int fr, int fq) {
    if (wr == 0) { const int r = wc * 64 + fr + 16 * fq; const f32x4 a = *(PG8_LAS const f32x4*)(raw + r * 8), b = *(PG8_LAS const f32x4*)(raw + r * 8 + 4);
        tab[r] = rstd_of(((a[0] + a[1]) + (a[2] + a[3])) + ((b[0] + b[1]) + (b[2] + b[3]))); }
    asm volatile("s_waitcnt lgkmcnt(0)" ::: "memory"); __builtin_amdgcn_s_barrier(); asm volatile("" ::: "memory");
}
struct EpiBf16 {
    static constexpr bool PERM = true, AFTER_DRAIN = false;
    bf16_t* O; int ldc; const float* rbias; const float* rss_row; const float* rss_col; PG8_LAS float* tab; PG8_LAS float* raw;
    __device__ __forceinline__ void prefetch(const Unit& u, int wid, int lane) const { if (rss_col) rss_prefetch(raw, rss_col, u.pn * BM, wid, lane); else if (rss_row) rss_prefetch(raw, rss_row, u.pm * BM, wid, lane); }
    __device__ __forceinline__ void operator()(const f32x4 (&acc)[2][2][4][2], const Unit& u, int wr, int wc, int fr, int fq) const {
        const int row0 = u.pm * BM + wr * 64 + fr, col0 = u.pn * BM + wc * 32 + 8 * fq;
        f32x4 cs[2][2];
#pragma unroll
        for (int bj = 0; bj < 2; ++bj)
#pragma unroll
            for (int n = 0; n < 2; ++n) cs[bj][n] = (f32x4){1.f, 1.f, 1.f, 1.f};
        if (rss_col) { rstd_table(tab, raw, wr, wc, fr, fq);
#pragma unroll
            for (int bj = 0; bj < 2; ++bj)
#pragma unroll
                for (int n = 0; n < 2; ++n) cs[bj][n] = *(const PG8_LAS f32x4*)(tab + bj * HALF + wc * 32 + 8 * fq + 4 * n); }
        if (rss_row) rstd_table(tab, raw, wr, wc, fr, fq);
#pragma unroll
        for (int ai = 0; ai < 2; ++ai)
#pragma unroll
            for (int m = 0; m < 4; ++m) { const int row = row0 + ai * HALF + m * 16; bf16_t* rowp = O + (size_t)row * ldc + col0; const float b = rbias ? rbias[row] : 0.f;
                const float rs = rss_row ? tab[ai * HALF + wr * 64 + m * 16 + fr] : 1.f;
#pragma unroll
                for (int bj = 0; bj < 2; ++bj) { const f32x4 v0 = acc[ai][bj][m][0] * cs[bj][0] * rs + b, v1 = acc[ai][bj][m][1] * cs[bj][1] * rs + b;
                    u32x4 w; w.x = cvt_pk_bf16(v0[0], v0[1]); w.y = cvt_pk_bf16(v0[2], v0[3]); w.z = cvt_pk_bf16(v1[0], v1[1]); w.w = cvt_pk_bf16(v1[2], v1[3]);
                    __builtin_nontemporal_store(w, (u32x4*)(rowp + bj * HALF)); } }
    }
};
struct EpiSwiGLU {
    static constexpr bool PERM = true, AFTER_DRAIN = false;
    bf16_t* O; int ldc; const float* rss_row; PG8_LAS float* tab; PG8_LAS float* raw;
    __device__ __forceinline__ void prefetch(const Unit& u, int wid, int lane) const { rss_prefetch(raw, rss_row, u.pm * BM, wid, lane); }
    static __device__ __forceinline__ f32x4 sw4(f32x4 g, f32x4 u, float c1, float rs2) {
        const f32x4 t = g * c1;
        f32x4 e; e[0] = __builtin_amdgcn_exp2f(t[0]); e[1] = __builtin_amdgcn_exp2f(t[1]); e[2] = __builtin_amdgcn_exp2f(t[2]); e[3] = __builtin_amdgcn_exp2f(t[3]);
        const f32x4 d = e + 1.0f;
        f32x4 r; r[0] = __builtin_amdgcn_rcpf(d[0]); r[1] = __builtin_amdgcn_rcpf(d[1]); r[2] = __builtin_amdgcn_rcpf(d[2]); r[3] = __builtin_amdgcn_rcpf(d[3]);
        return ((g * u) * rs2) * r;
    }
    __device__ __forceinline__ void operator()(const f32x4 (&acc)[2][2][4][2], const Unit& u, int wr, int wc, int fr, int fq) const {
        const int row0 = u.pm * BM + wr * 64 + fr, col0 = u.pn * HALF + wc * 32 + 8 * fq;
        rstd_table(tab, raw, wr, wc, fr, fq);
#pragma unroll
        for (int ai = 0; ai < 2; ++ai)
#pragma unroll
            for (int m = 0; m < 4; ++m) { const int row = row0 + ai * HALF + m * 16; bf16_t* rowp = O + (size_t)row * ldc + col0;
                const float rs = tab[ai * HALF + wr * 64 + m * 16 + fr], c1 = -1.4426950408889634f * rs, rs2 = rs * rs;
                const f32x4 h0 = sw4(acc[ai][0][m][0], acc[ai][1][m][0], c1, rs2), h1 = sw4(acc[ai][0][m][1], acc[ai][1][m][1], c1, rs2);
                u32x4 w; w.x = cvt_pk_bf16(h0[0], h0[1]); w.y = cvt_pk_bf16(h0[2], h0[3]); w.z = cvt_pk_bf16(h1[0], h1[1]); w.w = cvt_pk_bf16(h1[2], h1[3]);
                __builtin_nontemporal_store(w, (u32x4*)rowp); }
    }
};
struct EpiRes16 {
    static constexpr bool PERM = true, AFTER_DRAIN = false;
    bf16_t* XN; int ldc; const float* bias; float* OUT; float* rss; PG8_LAS float* part;
    __device__ __forceinline__ void prefetch(const Unit&, int, int) const {}
    __device__ __forceinline__ void operator()(const f32x4 (&acc)[2][2][4][2], const Unit& u, int wr, int wc, int fr, int fq) const {
        const int row0 = u.pm * BM + wr * 64 + fr, col0 = u.pn * BM + wc * 32 + 8 * fq;
        f32x4 bv[2][2];
#pragma unroll
        for (int bj = 0; bj < 2; ++bj)
#pragma unroll
            for (int n = 0; n < 2; ++n) bv[bj][n] = bias ? *(const f32x4*)(bias + col0 + bj * HALF + 4 * n) : (f32x4){0.f, 0.f, 0.f, 0.f};
        u32x4 xin[4][2];
#pragma unroll
        for (int m = 0; m < 4; ++m)
#pragma unroll
            for (int bj = 0; bj < 2; ++bj) xin[m][bj] = *(const u32x4*)(XN + (size_t)(row0 + m * 16) * ldc + col0 + bj * HALF);
#pragma unroll
        for (int ai = 0; ai < 2; ++ai) {
#pragma unroll
            for (int m = 0; m < 4; ++m) { const int row = row0 + ai * HALF + m * 16;
                float ss = 0.f;
                f32x4 xs[2][2];
#pragma unroll
                for (int bj = 0; bj < 2; ++bj) { const u32x4 xi = xin[m][bj];
                    f32x4 x0 = acc[ai][bj][m][0] + bv[bj][0], x1 = acc[ai][bj][m][1] + bv[bj][1];
                    x0[0] += __builtin_bit_cast(float, xi[0] << 16); x0[1] += __builtin_bit_cast(float, xi[0] & 0xffff0000u); x0[2] += __builtin_bit_cast(float, xi[1] << 16); x0[3] += __builtin_bit_cast(float, xi[1] & 0xffff0000u);
                    x1[0] += __builtin_bit_cast(float, xi[2] << 16); x1[1] += __builtin_bit_cast(float, xi[2] & 0xffff0000u); x1[2] += __builtin_bit_cast(float, xi[3] << 16); x1[3] += __builtin_bit_cast(float, xi[3] & 0xffff0000u);
                    xs[bj][0] = x0; xs[bj][1] = x1; }
                if (ai == 0) {
#pragma unroll
                    for (int bj = 0; bj < 2; ++bj) xin[m][bj] = *(const u32x4*)(XN + (size_t)(row0 + HALF + m * 16) * ldc + col0 + bj * HALF); }
#pragma unroll
                for (int bj = 0; bj < 2; ++bj) { const f32x4 x0 = xs[bj][0], x1 = xs[bj][1];
                    if (OUT) { float* op = OUT + (size_t)row * ldc + col0 + bj * HALF; *(f32x4*)op = x0; *(f32x4*)(op + 4) = x1; }
                    else { u32x4 w; w.x = cvt_pk_bf16(x0[0], x0[1]); w.y = cvt_pk_bf16(x0[2], x0[3]); w.z = cvt_pk_bf16(x1[0], x1[1]); w.w = cvt_pk_bf16(x1[2], x1[3]);
                        *(u32x4*)(XN + (size_t)row * ldc + col0 + bj * HALF) = w;
                        const float r0 = __builtin_bit_cast(float, w.x << 16), r1 = __builtin_bit_cast(float, w.x & 0xffff0000u), r2 = __builtin_bit_cast(float, w.y << 16), r3 = __builtin_bit_cast(float, w.y & 0xffff0000u);
                        const float r4 = __builtin_bit_cast(float, w.z << 16), r5 = __builtin_bit_cast(float, w.z & 0xffff0000u), r6 = __builtin_bit_cast(float, w.w << 16), r7 = __builtin_bit_cast(float, w.w & 0xffff0000u);
                        ss += ((r0 * r0 + r1 * r1) + (r2 * r2 + r3 * r3)) + ((r4 * r4 + r5 * r5) + (r6 * r6 + r7 * r7)); } }
                if (rss) {
                    { const unsigned us = __builtin_bit_cast(unsigned, ss); const auto r16 = __builtin_amdgcn_permlane16_swap(us, us, false, false); ss = __builtin_bit_cast(float, (unsigned)r16[0]) + __builtin_bit_cast(float, (unsigned)r16[1]); }
                    { const unsigned us = __builtin_bit_cast(unsigned, ss); const auto r32 = __builtin_amdgcn_permlane32_swap(us, us, false, false); ss = __builtin_bit_cast(float, (unsigned)r32[0]) + __builtin_bit_cast(float, (unsigned)r32[1]); }
                    if (fq == 0) part[(ai * HALF + wr * 64 + m * 16 + fr) * 4 + wc] = ss; } }
            asm volatile("" ::: "memory"); }
        if (rss) {
            asm volatile("s_waitcnt lgkmcnt(0)" ::: "memory"); __builtin_amdgcn_s_barrier(); asm volatile("" ::: "memory");
            if (wr == 0) { const int r = wc * 64 + fr + 16 * fq; const f32x4 p4 = *(const PG8_LAS f32x4*)(part + r * 4); rss[(size_t)(u.pm * BM + r) * 8 + u.pn] = (p4[0] + p4[1]) + (p4[2] + p4[3]); }
        }
    }
};
struct EpiTaps {
    static constexpr bool PERM = true, AFTER_DRAIN = false;
    unsigned short* O; int ldc;
    __device__ __forceinline__ void prefetch(const Unit&, int, int) const {}
    __device__ __forceinline__ void operator()(const f32x4 (&acc)[2][2][4][2], const Unit& u, int wr, int wc, int fr, int fq) const {
        const int row0 = u.pm * BM + wr * 64 + fr, col0 = u.pn * BM + wc * 32 + 8 * fq;
        float tt[2][8];
#pragma unroll
        for (int bj = 0; bj < 2; ++bj)
#pragma unroll
            for (int e = 0; e < 8; ++e) { const int i = col0 + bj * HALF + e; tt[bj][e] = (i < 8192) ? (float)i * (1.0f / 8191.0f) : (float)(i - 8192) * (1.0f / 16383.0f); }
#pragma unroll
        for (int ai = 0; ai < 2; ++ai)
#pragma unroll
            for (int m = 0; m < 4; ++m) { const int row = row0 + ai * HALF + m * 16; unsigned short* rowp = O + (size_t)row * ldc + col0;
                const float delta = 3.0701134573253944f + (float)(row & 2047) * (float)((15.350567286626973 - 3.0701134573253944) / 2047.0);
                const float nd = -1.4426950408889634f * delta;
#pragma unroll
                for (int bj = 0; bj < 2; ++bj) { const f32x4 v0 = acc[ai][bj][m][0], v1 = acc[ai][bj][m][1];
                    float r[8];
#pragma unroll
                    for (int e = 0; e < 4; ++e) { r[e] = v0[e] * __builtin_amdgcn_exp2f(tt[bj][e] * nd); r[4 + e] = v1[e] * __builtin_amdgcn_exp2f(tt[bj][4 + e] * nd); }
                    u32x4 w; w.x = cvt_pk_f16(r[0], r[1]); w.y = cvt_pk_f16(r[2], r[3]); w.z = cvt_pk_f16(r[4], r[5]); w.w = cvt_pk_f16(r[6], r[7]);
                    *(u32x4*)(rowp + bj * HALF) = w; } }
    }
};
template <class Epi, class Sched, bool ALIGN_EPI = false, bool SP2 = false>
__device__ __forceinline__ void gemm_phase(PG8_LAS unsigned char* lds, const Gemm g, const Sched& S, const Epi& E, const int wave_id) {
    int tid_; asm volatile("v_mbcnt_lo_u32_b32 %0, -1, 0\n\tv_mbcnt_hi_u32_b32 %0, -1, %0" : "=v"(tid_)); tid_ += wave_id * 64;
    const int tid = tid_, wid = __builtin_amdgcn_readfirstlane(tid >> 6), lane = tid & 63, wr = wid >> 2, wc = wid & 3, fr = lane & 15, fq = lane >> 4;
    const int K = g.K, nt = K / BK;
    unsigned voffA[2], voffB[2];
#pragma unroll
    for (int i = 0; i < 2; ++i) { int R, C; stage_rc(tid * 16 + i * 8192, R, C); const int Rb = Epi::PERM ? ((R & ~31) + perm32(R & 31)) : R;
        voffA[i] = (unsigned)(R * K + C) * 2u; voffB[i] = (unsigned)(Rb * K + C) * 2u; }
    const size_t kstep = (size_t)(BK * 2);
    const size_t hstep = (size_t)HALF * K * 2;
    const size_t tstep = 2 * hstep;
    const unsigned ldsw = (unsigned)wid * 1024u;
    const int aoff = lds_byte(wr * 64 + fr, fq * 8), boff = lds_byte(wc * 32 + fr, fq * 8);
#define PG8_SA(b, h) (((b) * 2 + (h)) * HTB)
#define PG8_SB(b, h) ((4 + (b) * 2 + (h)) * HTB)
#define PG8_STAGE(bufoff, gbase, voff) do { _Pragma("unroll") for (int _i = 0; _i < 2; ++_i) \
        __builtin_amdgcn_global_load_lds((const unsigned*)((const char*)(gbase) + (voff)[_i]), (PG8_LAS unsigned*)(lds + (bufoff) + ldsw + _i * 8192), 16, 0, 0); } while (0)
#define PG8_LDA(dst, b, h) do { _Pragma("unroll") for (int m = 0; m < 4; ++m) _Pragma("unroll") for (int k = 0; k < 2; ++k) dst[m][k] = *(const PG8_LAS bf16x8*)(lds + PG8_SA(b, h) + aoff + m * 2048 + k * 1024); } while (0)
#define PG8_LDB(dst, b, h) do { _Pragma("unroll") for (int n = 0; n < 2; ++n) _Pragma("unroll") for (int k = 0; k < 2; ++k) dst[n][k] = *(const PG8_LAS bf16x8*)(lds + PG8_SB(b, h) + boff + n * 2048 + k * 1024); } while (0)
#define PG8_MMA(ai, bj, At, Bt) do { __builtin_amdgcn_s_setprio(1); _Pragma("unroll") for (int m = 0; m < 4; ++m) _Pragma("unroll") for (int n = 0; n < 2; ++n) _Pragma("unroll") for (int k = 0; k < 2; ++k) \
        acc[ai][bj][m][n] = __builtin_amdgcn_mfma_f32_16x16x32_bf16(Bt[n][k], At[m][k], acc[ai][bj][m][n], 0, 0, 0); __builtin_amdgcn_s_setprio(0); } while (0)
#define PG8_WAIT_V(n) asm volatile("s_waitcnt vmcnt(" #n ")" ::: "memory")
#define PG8_WAIT_L(n) asm volatile("s_waitcnt lgkmcnt(" #n ")" ::: "memory")
#define PG8_BAR __builtin_amdgcn_s_barrier()
#define PG8_SCHED __builtin_amdgcn_sched_barrier(0)
    Unit cur, nxt; int ui = 0;
    if (!S.next(0, cur)) return;
    E.prefetch(cur, wid, lane);
    f32x4 acc[2][2][4][2];
#pragma unroll
    for (int a = 0; a < 2; ++a)
#pragma unroll
        for (int b = 0; b < 2; ++b)
#pragma unroll
            for (int m = 0; m < 4; ++m)
#pragma unroll
                for (int n = 0; n < 2; ++n) acc[a][b][m][n] = (f32x4){0.f, 0.f, 0.f, 0.f};
    bf16x8 At[4][2], B0[2][2], B1[2][2];
    const char* cA = (const char*)g.A + (size_t)cur.pm * tstep; const char* cB = (const char*)g.Bt + (size_t)cur.pn * tstep;
    S.a_ready(cur);
    if constexpr (SP2) {
        PG8_STAGE(PG8_SB(0, 0), cB, voffB); PG8_STAGE(PG8_SB(0, 1), cB + hstep, voffB); PG8_STAGE(PG8_SA(0, 0), cA, voffA); PG8_STAGE(PG8_SA(0, 1), cA + hstep, voffA);
        if (wr == 1) PG8_BAR;
        PG8_WAIT_V(2); PG8_BAR;
        PG8_STAGE(PG8_SB(1, 0), cB + kstep, voffB); PG8_STAGE(PG8_SA(1, 0), cA + kstep, voffA); PG8_STAGE(PG8_SB(1, 1), cB + hstep + kstep, voffB);
        PG8_WAIT_V(6); PG8_BAR;
    } else {
        PG8_STAGE(PG8_SB(0, 0), cB, voffB); PG8_STAGE(PG8_SA(0, 0), cA, voffA); PG8_STAGE(PG8_SB(0, 1), cB + hstep, voffB); PG8_STAGE(PG8_SA(0, 1), cA + hstep, voffA);
        if (wr == 1) PG8_BAR;
        PG8_WAIT_V(4); PG8_BAR;
        PG8_STAGE(PG8_SB(1, 0), cB + kstep, voffB); PG8_STAGE(PG8_SA(1, 0), cA + kstep, voffA); PG8_STAGE(PG8_SB(1, 1), cB + hstep + kstep, voffB);
        PG8_WAIT_V(6); PG8_BAR;
    }
    for (;;) {
        const bool has_next = S.next(ui + 1, nxt);
        const char* nA = has_next ? (const char*)g.A + (size_t)nxt.pm * tstep : cA; const char* nB = has_next ? (const char*)g.Bt + (size_t)nxt.pn * tstep : cB;
        for (int t = 0; t < nt; t += 2) {
            const bool last = (t == nt - 2);
            const char* a1 = cA + (size_t)(t + 1) * kstep;
            const char* a2 = last ? nA : cA + (size_t)(t + 2) * kstep; const char* b2 = last ? nB : cB + (size_t)(t + 2) * kstep;
            const char* a3 = a2 + kstep; const char* b3 = b2 + kstep;
            if (last && has_next) S.a_ready(nxt);
            if constexpr (SP2) {
            PG8_LDB(B0, 0, 0); PG8_LDB(B1, 0, 1); PG8_SCHED; PG8_LDA(At, 0, 0); PG8_STAGE(PG8_SA(1, 1), a1 + hstep, voffA);
            PG8_WAIT_V(8); PG8_WAIT_L(0); PG8_BAR; PG8_MMA(0, 0, At, B0); PG8_MMA(0, 1, At, B1); PG8_BAR; PG8_SCHED;
            PG8_LDA(At, 0, 1); PG8_STAGE(PG8_SB(0, 0), b2, voffB); PG8_STAGE(PG8_SB(0, 1), b2 + hstep, voffB); PG8_STAGE(PG8_SA(0, 0), a2, voffA);
            PG8_WAIT_V(8); PG8_WAIT_L(0); PG8_BAR; PG8_MMA(1, 0, At, B0); PG8_MMA(1, 1, At, B1); PG8_BAR; PG8_SCHED;
            PG8_LDB(B0, 1, 0); PG8_LDB(B1, 1, 1); PG8_SCHED; PG8_LDA(At, 1, 0); PG8_STAGE(PG8_SA(0, 1), a2 + hstep, voffA);
            PG8_WAIT_V(8); PG8_WAIT_L(0); PG8_BAR; PG8_MMA(0, 0, At, B0); PG8_MMA(0, 1, At, B1); PG8_BAR; PG8_SCHED;
            PG8_LDA(At, 1, 1); PG8_STAGE(PG8_SB(1, 0), b3, voffB); PG8_STAGE(PG8_SB(1, 1), b3 + hstep, voffB); PG8_STAGE(PG8_SA(1, 0), a3, voffA);
            PG8_WAIT_V(8); PG8_WAIT_L(0); PG8_BAR; PG8_MMA(1, 0, At, B0); PG8_MMA(1, 1, At, B1); PG8_BAR; PG8_SCHED;
            } else {
            PG8_LDB(B0, 0, 0); PG8_SCHED; PG8_LDA(At, 0, 0); PG8_STAGE(PG8_SA(1, 1), a1 + hstep, voffA);
            PG8_WAIT_L(8); PG8_BAR; PG8_WAIT_L(0); PG8_MMA(0, 0, At, B0); PG8_BAR; PG8_SCHED;
            PG8_LDB(B1, 0, 1); PG8_STAGE(PG8_SB(0, 0), b2, voffB);
            PG8_BAR; PG8_WAIT_L(0); PG8_MMA(0, 1, At, B1); PG8_BAR;
            PG8_LDA(At, 0, 1); PG8_STAGE(PG8_SA(0, 0), a2, voffA);
            PG8_BAR; PG8_WAIT_L(0); PG8_MMA(1, 0, At, B0); PG8_BAR; PG8_SCHED;
            PG8_STAGE(PG8_SB(0, 1), b2 + hstep, voffB);
            PG8_WAIT_V(6); PG8_BAR; PG8_MMA(1, 1, At, B1); PG8_BAR;
            PG8_LDB(B0, 1, 0); PG8_SCHED; PG8_LDA(At, 1, 0); PG8_STAGE(PG8_SA(0, 1), a2 + hstep, voffA);
            PG8_WAIT_L(8); PG8_BAR; PG8_WAIT_L(0); PG8_MMA(0, 0, At, B0); PG8_BAR; PG8_SCHED;
            PG8_LDB(B1, 1, 1); PG8_STAGE(PG8_SB(1, 0), b3, voffB);
            PG8_BAR; PG8_WAIT_L(0); PG8_MMA(0, 1, At, B1); PG8_BAR;
            PG8_LDA(At, 1, 1); PG8_STAGE(PG8_SA(1, 0), a3, voffA);
            PG8_BAR; PG8_WAIT_L(0); PG8_MMA(1, 0, At, B0); PG8_BAR; PG8_SCHED;
            PG8_STAGE(PG8_SB(1, 1), b3 + hstep, voffB);
            PG8_WAIT_V(6); PG8_BAR; PG8_MMA(1, 1, At, B1); PG8_BAR;
            }
        }
        if constexpr (ALIGN_EPI) { if (wr == 0) PG8_BAR; }
        if constexpr (!Epi::AFTER_DRAIN) { E(acc, cur, wr, wc, fr, fq); if (has_next) E.prefetch(nxt, wid, lane); S.done(cur); }
        if (!has_next) break;
#pragma unroll
        for (int a = 0; a < 2; ++a)
#pragma unroll
            for (int b = 0; b < 2; ++b)
#pragma unroll
                for (int m = 0; m < 4; ++m)
#pragma unroll
                    for (int n = 0; n < 2; ++n) acc[a][b][m][n] = (f32x4){0.f, 0.f, 0.f, 0.f};
        cur = nxt; cA = nA; cB = nB; ++ui;
        if constexpr (ALIGN_EPI) { if (wr == 1) PG8_BAR; }
    }
    PG8_WAIT_V(0);
    if constexpr (!ALIGN_EPI) { if (wr == 0) PG8_BAR; }
    PG8_BAR;
    if constexpr (Epi::AFTER_DRAIN) { E.fused(acc, cur, wr, wc, fr, fq, lds, wid, lane); S.done(cur); }
#undef PG8_SA
#undef PG8_SB
#undef PG8_STAGE
#undef PG8_LDA
#undef PG8_LDB
#undef PG8_MMA
#undef PG8_WAIT_V
#undef PG8_WAIT_L
#undef PG8_BAR
#undef PG8_SCHED
}
}

#define FC_AS3 __attribute__((address_space(3)))
#if defined(__HIP_DEVICE_COMPILE__)
#define FC_SINCOS(rev, s, c) do { (s) = __builtin_amdgcn_sinf(rev); (c) = __builtin_amdgcn_cosf(rev); } while (0)
#define FC_OPAQUE(v) asm volatile("" : "+v"(v))
#else
#define FC_OPAQUE(v) do {} while (0)
#include <cmath>
#define FC_SINCOS(rev, s, c) do { (s) = sinf(6.283185307179586f * (rev)); (c) = cosf(6.283185307179586f * (rev)); } while (0)
#endif
#include <utility>
#ifndef FC_HD
#define FC_HD __host__ __device__ __forceinline__
#endif
namespace fc {
typedef float cpx __attribute__((ext_vector_type(2)));
typedef float f4 __attribute__((ext_vector_type(4)));
#ifndef FC_AS3
#define FC_AS3
#endif
typedef FC_AS3 cpx* lptr;
typedef const FC_AS3 cpx* clptr;
FC_HD cpx cmul_c(cpx a, cpx b) { return cpx{a.x * b.x - a.y * b.y, a.x * b.y + a.y * b.x}; }
#if defined(__HIP_DEVICE_COMPILE__) && defined(FC_ASM_CMUL)
__device__ __forceinline__ cpx cmul(cpx a, cpx b) { cpx t, r;
    asm("v_pk_mul_f32 %0, %2, %3 op_sel:[1,1] op_sel_hi:[1,0]\n\tv_pk_fma_f32 %1, %2, %3, %0 op_sel:[0,0,0] op_sel_hi:[0,1,1] neg_lo:[0,0,1] neg_hi:[0,0,0]" : "=&v"(t), "=&v"(r) : "v"(a), "v"(b));
    return r; }
#else
FC_HD cpx cmul(cpx a, cpx b) { return cmul_c(a, b); }
#endif
#if defined(__HIP_DEVICE_COMPILE__) && defined(FC_ASM_CMULK)
__device__ __forceinline__ cpx cmul_k(cpx a, cpx b) { cpx t, r;
    asm("v_pk_mul_f32 %0, %2, %3 op_sel:[1,1] op_sel_hi:[1,0]\n\tv_pk_fma_f32 %1, %2, %3, %0 op_sel:[0,0,0] op_sel_hi:[0,1,1] neg_lo:[0,0,1] neg_hi:[0,0,0]" : "=&v"(t), "=&v"(r) : "v"(a), "v"(b));
    return r; }
#else
FC_HD cpx cmul_k(cpx a, cpx b) { return cmul_c(a, b); }
#endif
FC_HD cpx cadd(cpx a, cpx b) { return cpx{a.x + b.x, a.y + b.y}; }
FC_HD cpx csub(cpx a, cpx b) { return cpx{a.x - b.x, a.y - b.y}; }
FC_HD cpx cconj(cpx a) { return cpx{a.x, -a.y}; }
FC_HD constexpr int padi(int e) { return e + (e >> 4); }
FC_HD constexpr float c32(int m) {
    switch (m) { case 0: return 1.0f; case 1: return 0.98078528040323043f; case 2: return 0.92387953251128674f; case 3: return 0.83146961230254524f; case 4: return 0.70710678118654752f;
        case 5: return 0.55557023301960218f; case 6: return 0.38268343236508977f; case 7: return 0.19509032201612825f; case 8: return 0.0f; case 9: return -0.19509032201612825f;
        case 10: return -0.38268343236508977f; case 11: return -0.55557023301960218f; case 12: return -0.70710678118654752f; case 13: return -0.83146961230254524f; case 14: return -0.92387953251128674f;
        default: return -0.98078528040323043f; } }
FC_HD constexpr float s32(int m) {
    switch (m) { case 0: return 0.0f; case 1: return 0.19509032201612825f; case 2: return 0.38268343236508977f; case 3: return 0.55557023301960218f; case 4: return 0.70710678118654752f;
        case 5: return 0.83146961230254524f; case 6: return 0.92387953251128674f; case 7: return 0.98078528040323043f; case 8: return 1.0f; case 9: return 0.98078528040323043f;
        case 10: return 0.92387953251128674f; case 11: return 0.83146961230254524f; case 12: return 0.70710678118654752f; case 13: return 0.55557023301960218f; case 14: return 0.38268343236508977f;
        default: return 0.19509032201612825f; } }
template <int R> FC_HD constexpr int brev(int v) { int r = 0; for (int b = 1; b < R; b <<= 1) { r = (r << 1) | (v & 1); v >>= 1; } return r; }
template <int R, bool INV, int H, int P, bool ZU> FC_HD void dft_bfly(cpx (&c)[R]) {
    constexpr int blk = (P / H) * 2 * H, i = P % H, m = i * (16 / H);
    const cpx a = c[blk + i];
    cpx d;
    if constexpr (ZU && H == R / 2) d = a;
    else { const cpx b = c[blk + i + H]; c[blk + i] = cadd(a, b);
#if defined(__HIP_DEVICE_COMPILE__) && defined(FC_ASM_CMUL)
        if constexpr (m == 8) {
            cpx r;
            if (INV) asm("v_pk_add_f32 %0, %1, %2 op_sel:[1,1] op_sel_hi:[0,0] neg_lo:[1,0] neg_hi:[0,1]" : "=v"(r) : "v"(a), "v"(b));
            else     asm("v_pk_add_f32 %0, %1, %2 op_sel:[1,1] op_sel_hi:[0,0] neg_lo:[0,1] neg_hi:[1,0]" : "=v"(r) : "v"(a), "v"(b));
            c[blk + i + H] = r; return; }
#endif
        d = csub(a, b); }
    if constexpr (m == 0) c[blk + i + H] = d;
    else if constexpr (m == 8) c[blk + i + H] = INV ? cpx{-d.y, d.x} : cpx{d.y, -d.x};
    else { constexpr float wc = c32(m), ws = INV ? s32(m) : -s32(m); c[blk + i + H] = cmul_k(d, cpx{wc, ws}); }
}
template <int R, bool INV, int H, bool ZU, int... Ps> FC_HD void dft_stage(cpx (&c)[R], std::integer_sequence<int, Ps...>) { (dft_bfly<R, INV, H, Ps, ZU>(c), ...); }
template <int R, bool INV, int H, bool ZU> FC_HD void dft_stages(cpx (&c)[R]) {
    dft_stage<R, INV, H, ZU>(c, std::make_integer_sequence<int, R / 2>{});
    if constexpr (H > 1) dft_stages<R, INV, H / 2, ZU>(c);
}
template <int R, bool INV, bool ZU = false> FC_HD void dft_reg(cpx (&c)[R]) { dft_stages<R, INV, R / 2, ZU>(c); }
template <int M, int S, int R, bool INV, int NT, int ZH = 0, bool WM = false> FC_HD void fft_pass(lptr lds, int tid) {
    constexpr int T = S / R, IT = (M / R) / NT;
    FC_OPAQUE(tid);
    for (int it = 0; it < (IT > 0 ? IT : 1); ++it) {
        const int b = WM ? (tid & ~63) * IT + (tid & 63) + 64 * it : tid + NT * it;
        if (b >= M / R) break;
        const int j = b % T, blk = b / T, base = blk * S + j;
        static_assert(T % 16 == 0 || (T == 1 && R <= 16), "padded index must be linear in k");
        constexpr int TS = (T % 16 == 0) ? T + T / 16 : 1;
        const int pb = padi(base);
        cpx c[R];
#pragma unroll
        for (int k = 0; k < R; ++k) { if (ZH == 1 && k >= R / 2) c[k] = cpx{0.f, 0.f}; else c[k] = lds[pb + k * TS]; }
        cpx w1 = cpx{1.f, 0.f};
        if (T > 1) { float s, co; FC_SINCOS((float)j * (1.0f / (float)S), s, co); w1 = cpx{co, INV ? s : -s}; }
        cpx w4 = cpx{1.f, 0.f}, cur[4];
        if (T > 1) { const cpx w2 = cmul_c(w1, w1); cur[0] = cpx{1.f, 0.f}; cur[1] = w1; cur[2] = w2; cur[3] = cmul_c(w2, w1); w4 = cmul_c(w2, w2); }
        if (INV && T > 1) {
#pragma unroll
            for (int k0 = 0; k0 < R; k0 += 4) {
#pragma unroll
                for (int i = 0; i < 4; ++i) { if (k0 + i > 0) c[k0 + i] = cmul(c[k0 + i], cur[i]); if (k0 + 4 < R) cur[i] = cmul(cur[i], w4); }
            }
        }
        dft_reg<R, INV, ZH == 1>(c);
        if (!INV && T > 1) {
#pragma unroll
            for (int k0 = 0; k0 < R; k0 += 4) {
#pragma unroll
                for (int i = 0; i < 4; ++i) { if (k0 + i > 0) c[brev<R>(k0 + i)] = cmul(c[brev<R>(k0 + i)], cur[i]); if (k0 + 4 < R) cur[i] = cmul(cur[i], w4); }
            }
        }
#pragma unroll
        for (int k = 0; k < (ZH == 2 ? R / 2 : R); ++k) lds[pb + k * TS] = c[brev<R>(k)];
    }
}
template <int M> struct Radix;
template <> struct Radix<8192>  { static constexpr int R1 = 32, R2 = 16, R3 = 16; };
template <> struct Radix<16384> { static constexpr int R1 = 32, R2 = 32, R3 = 16; };
template <int M> FC_HD int fpos(int f) { typedef Radix<M> X; return (f % X::R1) * (M / X::R1) + ((f / X::R1) % X::R2) * X::R3 + (f / (X::R1 * X::R2)); }
template <int M> FC_HD int qfreq(int q) { typedef Radix<M> X; const int k3 = q % (X::R3 / 2), k2 = (q / (X::R3 / 2)) % X::R2, k1 = q / ((X::R3 / 2) * X::R2); return k1 + X::R1 * (k2 + X::R2 * k3); }

#if defined(__HIP_DEVICE_COMPILE__)
#define FC_WSYNC asm volatile("s_waitcnt lgkmcnt(0)" ::: "memory")
#else
#define FC_WSYNC do {} while (0)
#endif
#define FC_FWD(M, NT, lds, tid, SYNC) do { typedef fc::Radix<M> X_; fc::fft_pass<M, M, X_::R1, false, NT>(lds, tid); SYNC; fc::fft_pass<M, M / X_::R1, X_::R2, false, NT, 0, true>(lds, tid); FC_WSYNC; \
    fc::fft_pass<M, X_::R3, X_::R3, false, NT, 0, true>(lds, tid); SYNC; } while (0)
#define FC_FWD12Z(M, NT, lds, tid, SYNC) do { typedef fc::Radix<M> X_; fc::fft_pass<M, M, X_::R1, false, NT, 1>(lds, tid); SYNC; fc::fft_pass<M, M / X_::R1, X_::R2, false, NT, 0, true>(lds, tid); FC_WSYNC; } while (0)
#define FC_FWD3(M, NT, lds, tid, SYNC) do { typedef fc::Radix<M> X_; fc::fft_pass<M, X_::R3, X_::R3, false, NT, 0, true>(lds, tid); SYNC; } while (0)
#define FC_INVZ(M, NT, lds, tid, SYNC) do { typedef fc::Radix<M> X_; fc::fft_pass<M, X_::R3, X_::R3, true, NT, 0, true>(lds, tid); FC_WSYNC; fc::fft_pass<M, M / X_::R1, X_::R2, true, NT, 0, true>(lds, tid); SYNC; \
    fc::fft_pass<M, M, X_::R1, true, NT, 2>(lds, tid); SYNC; } while (0)

#if defined(__HIP_DEVICE_COMPILE__) && defined(FC_ASM_CMUL)
__device__ __forceinline__ void untangle(cpx Zf, cpx Zg, cpx w, cpx& Xf, cpx& Xg) {
    cpx A, D, t, u;
    asm("v_pk_add_f32 %0, %6, %7 neg_hi:[0,1]\n\t"
        "v_pk_add_f32 %1, %6, %7 neg_lo:[0,1]\n\t"
        "v_pk_mul_f32 %2, %8, %1 op_sel:[1,1] op_sel_hi:[1,0]\n\t"
        "v_pk_fma_f32 %3, %8, %1, %2 op_sel:[0,0,0] op_sel_hi:[0,1,1] neg_lo:[0,0,1] neg_hi:[0,0,0]\n\t"
        "v_pk_add_f32 %4, %0, %3 op_sel:[0,1] op_sel_hi:[1,0] neg_hi:[0,1]\n\t"
        "v_pk_add_f32 %5, %0, %3 op_sel:[0,1] op_sel_hi:[1,0] neg_lo:[0,1] neg_hi:[1,1]"
        : "=&v"(A), "=&v"(D), "=&v"(t), "=&v"(u), "=&v"(Xf), "=&v"(Xg) : "v"(Zf), "v"(Zg), "v"(w));
}
__device__ __forceinline__ void retangle(cpx Yf, cpx Yg, cpx w, cpx& Zf, cpx& Zg) {
    cpx P, D, t, u;
    asm("v_pk_add_f32 %0, %6, %7 neg_hi:[0,1]\n\t"
        "v_pk_add_f32 %1, %6, %7 neg_lo:[0,1]\n\t"
        "v_pk_mul_f32 %2, %1, %8 op_sel:[1,1] op_sel_hi:[0,1]\n\t"
        "v_pk_fma_f32 %3, %1, %8, %2 op_sel:[0,0,0] op_sel_hi:[1,0,1] neg_lo:[0,0,0] neg_hi:[0,0,1]\n\t"
        "v_pk_add_f32 %4, %0, %3 op_sel:[0,1] op_sel_hi:[1,0] neg_lo:[0,1]\n\t"
        "v_pk_add_f32 %5, %0, %3 op_sel:[0,1] op_sel_hi:[1,0] neg_hi:[1,0]"
        : "=&v"(P), "=&v"(D), "=&v"(t), "=&v"(u), "=&v"(Zf), "=&v"(Zg) : "v"(Yf), "v"(Yg), "v"(w));
}
#else
FC_HD void untangle(cpx Zf, cpx Zg, cpx w, cpx& Xf, cpx& Xg) {
    const cpx A = cpx{Zf.x + Zg.x, Zf.y - Zg.y}, D = cpx{Zf.x - Zg.x, Zf.y + Zg.y};
    const cpx t = cmul_c(w, D);
    Xf = cpx{A.x + t.y, A.y - t.x}; Xg = cpx{A.x - t.y, -A.y - t.x};
}
FC_HD void retangle(cpx Yf, cpx Yg, cpx w, cpx& Zf, cpx& Zg) {
    const cpx P = cpx{Yf.x + Yg.x, Yf.y - Yg.y}, D = cpx{Yf.x - Yg.x, Yf.y + Yg.y};
    const cpx u = cpx{D.x * w.x + D.y * w.y, D.y * w.x - D.x * w.y};
    Zf = cpx{P.x - u.y, P.y + u.x}; Zg = cpx{P.x + u.y, -P.y + u.x};
}
#endif
template <int M> FC_HD cpx wstep() { return M == 8192 ? cpx{0.9999997058628822f, -0.0007669903187427045f} : cpx{0.9999999264657179f, -0.00038349518757139556f}; }
template <int M, int NT> struct PairIdx {
    typedef Radix<M> X;
    static constexpr int NJ = (M / 2) / NT, PS = 2 * (M / X::R1), PSP = PS + PS / 16;
    static_assert(NT == (X::R3 / 2) * X::R2 * 2, "thread count vs radix split");
    int f0, pf0, pg0, pgA;
    FC_HD void init(int tid) {
        const int k3 = tid % (X::R3 / 2), k2 = (tid / (X::R3 / 2)) % X::R2, k1b = tid / ((X::R3 / 2) * X::R2);
        f0 = k1b + X::R1 * (k2 + X::R2 * k3);
        pf0 = padi(k1b * (M / X::R1) + k2 * X::R3 + k3);
        pg0 = padi(fpos<M>((M - f0) % M));
        pgA = padi((X::R1 - k1b) * (M / X::R1) + (X::R2 - 1 - k2) * X::R3 + (X::R3 - 1 - k3));
    }
    FC_HD int pf(int jj) const { return pf0 + jj * PSP; }
    FC_HD int pg(int jj) const { return jj == 0 ? pg0 : pgA - jj * PSP; }
};
template <int M, int NT> FC_HD void filter_pass(clptr lds, int tid, float sc, f4* kb) {
    FC_OPAQUE(tid);
    PairIdx<M, NT> ix; ix.init(tid);
    float s, co; FC_SINCOS((float)ix.f0 * (0.5f / (float)M), s, co); cpx w = cpx{co, -s}; const cpx d = wstep<M>();
#pragma unroll
    for (int jj = 0; jj < PairIdx<M, NT>::NJ; ++jj) {
        const cpx Zf = lds[ix.pf(jj)], Zg = lds[ix.pg(jj)];
        cpx Xf, Xg; untangle(Zf, Zg, w, Xf, Xg);
        kb[jj * NT + tid] = f4{Xf.x * sc, Xf.y * sc, Xg.x * sc, Xg.y * sc};
        w = cmul_c(w, d);
    }
    if (tid == 0) { const cpx Z = lds[padi(fpos<M>(M / 2))]; cpx Xf, Xg; untangle(Z, Z, cpx{0.f, -1.f}, Xf, Xg);
        kb[M / 2] = f4{Xf.x * sc, Xf.y * sc, Xg.x * sc, Xg.y * sc}; }
}
template <int M, int NT> struct KRegs { f4 k[(M / 2) / NT]; f4 kx; };
template <int M, int NT> FC_HD void k_prefetch(const f4* kb, int tid, KRegs<M, NT>& r) {
#pragma unroll
    for (int jj = 0; jj < (M / 2) / NT; ++jj) r.k[jj] = kb[jj * NT + tid];
    r.kx = kb[M / 2];
}
template <int M, int NT> FC_HD void mult_pass(lptr lds, int tid, const KRegs<M, NT>& r) {
    FC_OPAQUE(tid);
    PairIdx<M, NT> ix; ix.init(tid);
    float s, co; FC_SINCOS((float)ix.f0 * (0.5f / (float)M), s, co); cpx w = cpx{co, -s}; const cpx d = wstep<M>();
#pragma unroll
    for (int jj = 0; jj < PairIdx<M, NT>::NJ; ++jj) {
        const int pf = ix.pf(jj), pg = ix.pg(jj);
        const cpx Zf = lds[pf], Zg = lds[pg];
        cpx Xf, Xg; untangle(Zf, Zg, w, Xf, Xg);
        const f4 k = r.k[jj];
        const cpx Yf = cmul(Xf, cpx{k[0], k[1]}), Yg = cmul(Xg, cpx{k[2], k[3]});
        cpx Of, Og; retangle(Yf, Yg, w, Of, Og);
        lds[pf] = Of; if (jj != 0 || ix.f0 != 0) lds[pg] = Og;
        w = cmul_c(w, d);
    }
    if (tid == 0) { const int p = padi(fpos<M>(M / 2)); const cpx Z = lds[p]; const cpx w2 = cpx{0.f, -1.f}; cpx Xf, Xg; untangle(Z, Z, w2, Xf, Xg);
        const f4 k = r.kx; const cpx Yf = cmul(Xf, cpx{k[0], k[1]}), Yg = cmul(Xg, cpx{k[2], k[3]}); cpx Of, Og; retangle(Yf, Yg, w2, Of, Og); lds[p] = Of; }
}
}

constexpr int NWAVES = 8;
constexpr int D = 2048, NTOK = 49152, NTOKP = 32768, LP = 8192, LS = 16384, NBP = 4;
constexpr int DFF = 5632, NGU = 2 * DFF, NQKV = 3072, NHY = 3 * D;
constexpr int HT_ROWS = 8192, HT_COLS = LP + LS;
constexpr int NHEAD = 16, HD = 128, NKV = 4;
constexpr float EPS = 1e-6f;
#ifndef MK_PER_PHASE
#define MK_PER_PHASE 0
#endif
constexpr int NPHASE = 23;
#ifndef EN_MASK
#define EN_MASK 0xffff
#endif

constexpr size_t MiB = 1u << 20;
constexpr size_t WS_CTL = 0, CTL_ZERO_BYTES = 64 * 1024;
constexpr size_t WS_RSS = 1 * MiB;
constexpr size_t WS_WMA = 4 * MiB;
constexpr size_t WS_WMB = 28 * MiB;
constexpr size_t WS_WGU = 36 * MiB;
constexpr size_t WS_WDN = 80 * MiB;
constexpr size_t WS_A3X = 102 * MiB;
constexpr size_t WS_WOX = 126 * MiB;
constexpr size_t WS_XN = 134 * MiB;
constexpr size_t WS_HT = 326 * MiB;
constexpr size_t WS_BIG = 710 * MiB;
constexpr size_t WS_KB = 1286 * MiB;
constexpr int KB_ORDER = 8256;
constexpr int KB_BLOCK = 2 * KB_ORDER + 4096;
constexpr size_t WS_END = WS_KB + (size_t)256 * KB_BLOCK * 16;
static_assert(WS_END <= 1400 * MiB, "ws map");
constexpr int CW_BAR = 4096;

constexpr int LDS_BYTES = 147456;
constexpr int MISC_OFF = 146432;
constexpr int RED_OFF = 145408;
constexpr int PTAB_OFF = MISC_OFF + 256;

typedef __attribute__((address_space(3))) float pg8_las_f;
#define GAS __attribute__((address_space(1)))
#define LAS __attribute__((address_space(3)))
typedef unsigned short bf16;
typedef unsigned v4u __attribute__((ext_vector_type(4)));
typedef unsigned v2u __attribute__((ext_vector_type(2)));
typedef float f32x4 __attribute__((ext_vector_type(4)));
typedef float f32x16 __attribute__((ext_vector_type(16)));
typedef short bf16x8 __attribute__((ext_vector_type(8)));
typedef short s16x4 __attribute__((ext_vector_type(4)));
typedef GAS unsigned gu32;
#define RLX_AGENT __ATOMIC_RELAXED, __HIP_MEMORY_SCOPE_AGENT
#define LDS_WAIT() asm volatile("s_waitcnt lgkmcnt(0)" ::: "memory")
__device__ __forceinline__ unsigned f2bf(float f) { unsigned u = __builtin_bit_cast(unsigned, f); return (u + 0x7fffu + ((u >> 16) & 1u)) >> 16; }
__device__ __forceinline__ unsigned pk2(float lo, float hi) { unsigned r; asm("v_cvt_pk_bf16_f32 %0, %1, %2" : "=v"(r) : "v"(lo), "v"(hi)); return r; }
__device__ __forceinline__ float bf_lo(unsigned w) { return __builtin_bit_cast(float, w << 16); }
__device__ __forceinline__ float bf_hi(unsigned w) { return __builtin_bit_cast(float, w & 0xffff0000u); }
__device__ __forceinline__ float h2f(unsigned short h) { return (float)__builtin_bit_cast(_Float16, h); }
__device__ __forceinline__ float dpp_f(float v, int ctrl_sel) {
    const int b = __builtin_bit_cast(int, v); int r;
    if (ctrl_sel == 0) r = __builtin_amdgcn_update_dpp(0, b, 0xB1, 0xF, 0xF, true);
    else if (ctrl_sel == 1) r = __builtin_amdgcn_update_dpp(0, b, 0x4E, 0xF, 0xF, true);
    else if (ctrl_sel == 2) r = __builtin_amdgcn_update_dpp(0, b, 0x141, 0xF, 0xF, true);
    else r = __builtin_amdgcn_update_dpp(0, b, 0x140, 0xF, 0xF, true);
    return __builtin_bit_cast(float, r);
}
__device__ __forceinline__ float sum16(float v) { v += dpp_f(v, 0); v += dpp_f(v, 1); v += dpp_f(v, 2); v += dpp_f(v, 3); return v; }
__device__ __forceinline__ float sum_halves(float v) { const unsigned u = __builtin_bit_cast(unsigned, v); const auto rr = __builtin_amdgcn_permlane32_swap(u, u, false, false);
    return __builtin_bit_cast(float, (unsigned)rr[0]) + __builtin_bit_cast(float, (unsigned)rr[1]); }
__device__ __forceinline__ float max_halves(float v) { const unsigned u = __builtin_bit_cast(unsigned, v); const auto rr = __builtin_amdgcn_permlane32_swap(u, u, false, false);
    return fmaxf(__builtin_bit_cast(float, (unsigned)rr[0]), __builtin_bit_cast(float, (unsigned)rr[1])); }
__device__ __forceinline__ float rdlane_f(float v, int l) { return __builtin_bit_cast(float, __builtin_amdgcn_readlane(__builtin_bit_cast(int, v), l)); }
__device__ __forceinline__ float wave_sum(float v, int  ) { v = sum16(v); return (rdlane_f(v, 0) + rdlane_f(v, 16)) + (rdlane_f(v, 32) + rdlane_f(v, 48)); }

#define XB_TMO      128
#define XB_XCNT(j)  (256  + 64 * (j))
#define XB_XSUB(j)  (1280 + 64 * (j))
#define XB_XGEN(j)  (2304 + 64 * (j))
#define XB_TOP      3328
#define XB_TOPGEN   3392
#define XCD_BAR_WORDS 3456
#define XB_SPIN_CAP (1u << 18)

__device__ __forceinline__ unsigned xb_ld(unsigned* p)              { return __hip_atomic_load(p, __ATOMIC_RELAXED, __HIP_MEMORY_SCOPE_AGENT); }
__device__ __forceinline__ unsigned xb_add(unsigned* p, unsigned v) { return __hip_atomic_fetch_add(p, v, __ATOMIC_RELAXED, __HIP_MEMORY_SCOPE_AGENT); }
__device__ __forceinline__ unsigned xb_xcc_id() { return (unsigned)__builtin_amdgcn_s_getreg((3 << 11) | 20) & 0xFu; }
#define XB_SPIN(cond, bar) do { unsigned _sp = 0; while (cond) { __builtin_amdgcn_s_sleep(1); \
    if ((++_sp & 255u) == 0u) { if (xb_ld(&(bar)[XB_TMO])) break; if (_sp > XB_SPIN_CAP) { atomicAdd(&(bar)[XB_TMO], 1u); break; } } } } while (0)

struct XcdBarrier {
    unsigned* bar; unsigned x;
    volatile LAS unsigned* st;
};

__device__ __forceinline__ XcdBarrier xcd_barrier_post(unsigned* bar, volatile LAS unsigned* st) {
    XcdBarrier b; b.bar = bar; b.x = xb_xcc_id(); b.st = st;
    if (threadIdx.x == 0) (void)xb_add(&bar[XB_XCNT(b.x)], 1u);
    return b;
}
__device__ __forceinline__ void xcd_barrier_complete(unsigned* bar, unsigned x, unsigned& nloc, unsigned& nx) {
    const unsigned G = gridDim.x * gridDim.y * gridDim.z;
    unsigned sum, cnt, mine, sp = 0u;
    for (;;) {
        sum = 0u; cnt = 0u; mine = 0u;
#pragma unroll
        for (unsigned j = 0; j < 16; ++j) { const unsigned c = xb_ld(&bar[XB_XCNT(j)]); sum += c; cnt += (c > 0u) ? 1u : 0u; mine = (j == x) ? c : mine; }
        if (sum == G) break;
        __builtin_amdgcn_s_sleep(1);
        if ((++sp & 255u) == 0u) { if (xb_ld(&bar[XB_TMO])) break; if (sp > XB_SPIN_CAP) { atomicAdd(&bar[XB_TMO], 1u); break; } }
    }
    nloc = mine > 0u ? mine : 1u; nx = cnt > 0u ? cnt : 1u;
}

__device__ __forceinline__ void xcd_barrier(const XcdBarrier& b) {
    asm volatile("s_waitcnt vmcnt(0)" ::: "memory");
    __syncthreads();
    if (threadIdx.x == 0) {
        unsigned* bar = b.bar;
        __builtin_amdgcn_s_waitcnt(0);
        unsigned nloc = b.st[0], nx = b.st[1];
        if (nloc == 0u) { xcd_barrier_complete(bar, b.x, nloc, nx); b.st[0] = nloc; b.st[1] = nx; }
        const unsigned old = xb_add(&bar[XB_XSUB(b.x)], 1u);
        const unsigned gen = old / nloc;
        if (old + 1u == (gen + 1u) * nloc) {
            __builtin_amdgcn_fence(__ATOMIC_RELEASE, "agent");
            asm volatile("s_waitcnt vmcnt(0)" ::: "memory");
            const unsigned og = xb_add(&bar[XB_TOP], 1u);
            const unsigned tg = og / nx;
            if (og + 1u == (tg + 1u) * nx) xb_add(&bar[XB_TOPGEN], 1u);
            else XB_SPIN(xb_ld(&bar[XB_TOPGEN]) == tg, bar);
            __builtin_amdgcn_fence(__ATOMIC_ACQUIRE, "agent");
            xb_add(&bar[XB_XGEN(b.x)], 1u);
            asm volatile("s_waitcnt vmcnt(0)" ::: "memory");
        } else {
            XB_SPIN(xb_ld(&bar[XB_XGEN(b.x)]) == gen, bar);
            __builtin_amdgcn_fence(__ATOMIC_ACQUIRE, "agent");
            asm volatile("s_waitcnt vmcnt(0)" ::: "memory");
        }
    }
    __syncthreads();
}

struct Args {
    const float* in[27]; float* out; unsigned char* ws; int ph_lo, ph_hi, dry, pad;
};
struct Frame {
    LAS unsigned char* lds;
    int tid, lane, wave, vcu, G, bx;
    __device__ __forceinline__ const float* inp(int i) const {
        volatile LAS unsigned* t = (volatile LAS unsigned*)(lds + PTAB_OFF) + 2 * i;
        const unsigned lo = __builtin_amdgcn_readfirstlane(t[0]), hi = __builtin_amdgcn_readfirstlane(t[1]);
        return (const float*)(const GAS float*)(((unsigned long long)hi << 32) | lo);
    }
    __device__ __forceinline__ float* outp() const { return (float*)inp(27); }
    __device__ __forceinline__ unsigned char* wsp() const { return (unsigned char*)inp(28); }
};
#define OPAQUE_V(v) asm volatile("" : "+v"(v))
#define OPAQUE_S(v) asm volatile("" : "+s"(v))
#define PH_FRAME(Fp) Frame Fp = F; OPAQUE_S(Fp.lds); OPAQUE_S(Fp.wave); OPAQUE_S(Fp.vcu); OPAQUE_S(Fp.G); OPAQUE_S(Fp.bx); asm volatile("v_mbcnt_lo_u32_b32 %0, -1, 0\n\tv_mbcnt_hi_u32_b32 %0, -1, %0" : "=v"(Fp.lane)); Fp.tid = Fp.wave * 64 + Fp.lane

struct CvtRegs { float w[32]; f32x4 g0, g1; };
__device__ __forceinline__ void cvt_load(const float* W, const float* gain, int N, int item, int lane, CvtRegs& r) {
    const int nblk = N / 32, kb = item / nblk, nb = item % nblk, k0 = 64 * kb, n0 = 32 * nb;
    if (gain) { r.g0 = *(const GAS f32x4*)(gain + k0 + 8 * (lane & 7)); r.g1 = *(const GAS f32x4*)(gain + k0 + 8 * (lane & 7) + 4); } else { r.g0 = (f32x4){1.f, 1.f, 1.f, 1.f}; r.g1 = r.g0; }
#pragma unroll
    for (int i = 0; i < 32; ++i) r.w[i] = W[(size_t)(k0 + 2 * i + (lane >> 5)) * N + n0 + (lane & 31)];
}
template <int MODE> __device__ __forceinline__ void cvt_store(const CvtRegs& r, int K, int N, bf16* WT, LAS float* scr, int item, int lane) {
    const int nblk = N / 32, kb = item / nblk, nb = item % nblk, k0 = 64 * kb, n0 = 32 * nb;
#pragma unroll
    for (int i = 0; i < 32; ++i) { const int kk = 2 * i + (lane >> 5); scr[kk * 33 + (lane & 31)] = r.w[i]; }
    LDS_WAIT(); asm volatile("" ::: "memory");
    const int c = lane & 7;
    int r0 = n0; if (MODE == 1) { const int half = n0 / DFF, rr = n0 % DFF; r0 = (rr / 128) * 256 + half * 128 + (rr % 128); }
#pragma unroll
    for (int j = 0; j < 4; ++j) { const int n = (lane >> 3) + 8 * j; const LAS float* s = scr + (8 * c) * 33 + n;
        v4u o; o.x = pk2(s[0 * 33] * r.g0.x, s[1 * 33] * r.g0.y); o.y = pk2(s[2 * 33] * r.g0.z, s[3 * 33] * r.g0.w); o.z = pk2(s[4 * 33] * r.g1.x, s[5 * 33] * r.g1.y); o.w = pk2(s[6 * 33] * r.g1.z, s[7 * 33] * r.g1.w);
        *(GAS v4u*)(WT + (size_t)(r0 + n) * K + k0 + 8 * c) = o; }
    LDS_WAIT(); asm volatile("" ::: "memory");
}
template <int MODE> __device__ __forceinline__ void cvt_weight(const Frame& F, const float* W, const float* gain, int K, int N, bf16* WT) {
    LAS float* scr = (LAS float*)(F.lds + F.wave * 8704);
    const int gw = F.vcu * NWAVES + F.wave, NGW = F.G * NWAVES, nitems = (K / 64) * (N / 32);
    CvtRegs cur, nxt;
    if (gw < nitems) cvt_load(W, gain, N, gw, F.lane, cur);
    for (int it = gw; it < nitems; it += NGW) {
        const bool more = it + NGW < nitems;
        if (more) cvt_load(W, gain, N, it + NGW, F.lane, nxt);
        cvt_store<MODE>(cur, K, N, WT, scr, it, F.lane);
        if (more) { cur.g0 = nxt.g0; cur.g1 = nxt.g1;
#pragma unroll
            for (int i = 0; i < 32; ++i) cur.w[i] = nxt.w[i]; }
    }
}
__device__ __forceinline__ void prep_rows(const Frame& F, const float* xa, const float* xb, bf16* XN, float* rss) {
    const int gw = F.vcu * NWAVES + F.wave, NGW = F.G * NWAVES;
    f32x4 v[8], nx[8];
    if (gw < NTOK) { const GAS f32x4* xr = (const GAS f32x4*)((gw < NTOKP) ? xa + (size_t)gw * D : xb + (size_t)(gw - NTOKP) * D) + F.lane;
#pragma unroll
        for (int j = 0; j < 8; ++j) nx[j] = xr[64 * j]; }
    for (int m = gw; m < NTOK; m += NGW) {
#pragma unroll
        for (int j = 0; j < 8; ++j) v[j] = nx[j];
        { const int mn = (m + NGW < NTOK) ? m + NGW : m;
          const GAS f32x4* xr = (const GAS f32x4*)((mn < NTOKP) ? xa + (size_t)mn * D : xb + (size_t)(mn - NTOKP) * D) + F.lane;
#pragma unroll
          for (int j = 0; j < 8; ++j) nx[j] = xr[64 * j]; }
        float s = 0.f;
#pragma unroll
        for (int j = 0; j < 8; ++j) {
            const float a = bf_lo(f2bf(v[j].x)), b = bf_lo(f2bf(v[j].y)), c = bf_lo(f2bf(v[j].z)), d = bf_lo(f2bf(v[j].w)); s += (a * a + b * b) + (c * c + d * d); }
        s = wave_sum(s, F.lane);
        if (F.lane < 8) rss[(size_t)m * 8 + F.lane] = (F.lane == 0) ? s : 0.f;
        GAS v2u* o = (GAS v2u*)(XN + (size_t)m * D) + F.lane;
#pragma unroll
        for (int j = 0; j < 8; ++j) { v2u w; w.x = pk2(v[j].x, v[j].y); w.y = pk2(v[j].z, v[j].w); o[64 * j] = w; }
    }
}
__device__ __forceinline__ float rdlane(float v, int k) { return __builtin_bit_cast(float, __builtin_amdgcn_readlane(__builtin_bit_cast(int, v), k)); }
__device__ __forceinline__ void filter_mlp(const Frame& F, bf16* A3X, bf16* WOX) {
    const int gw = F.vcu * NWAVES + F.wave, NGW = F.G * NWAVES, lane = F.lane;
    for (int it = gw; it < 2 * HT_COLS; it += NGW) {
        const int j = it / HT_COLS, ip = it % HT_COLS;
        const int L = ip < LP ? LP : LS, i = ip < LP ? ip : ip - LP;
        const float* w1 = F.inp(8) + (size_t)j * 33 * 64; const float* b1 = F.inp(9) + j * 64; const float* w2 = F.inp(10) + (size_t)j * 64 * 64; const float* b2 = F.inp(11) + j * 64;
        const float* w3 = F.inp(12) + (size_t)j * 64 * 64; const float* b3 = F.inp(13) + j * 64; const float fr = F.inp(15)[j * 64 + lane];
        const float t = (float)i / (float)(L - 1);
        const float wang = (6.2831853071795864769f * (float)i) / (float)L;
        float feat = 0.f;
        if (lane == 0) feat = t;
        else if (lane <= 32) { const int b = (lane - 1) & 15; const float fb = (float)(1e-4 + (double)b * ((15.0 - 1e-4) / 15.0)); const float ang = wang * fb; feat = (lane <= 16) ? cosf(ang) : -sinf(ang); }
        float acc = b1[lane];
#pragma unroll
        for (int k = 0; k < 33; ++k) acc += rdlane(feat, k) * w1[k * 64 + lane];
        float a = sinf(fr * acc);
        acc = b2[lane];
#pragma unroll 16
        for (int k = 0; k < 64; ++k) acc += rdlane(a, k) * w2[k * 64 + lane];
        a = sinf(fr * acc);
        acc = b3[lane];
#pragma unroll 16
        for (int k = 0; k < 64; ++k) acc += rdlane(a, k) * w3[k * 64 + lane];
        a = sinf(fr * acc);
        const unsigned hi = f2bf(a); const float rem = a - __builtin_bit_cast(float, hi << 16); const unsigned lo = f2bf(rem);
        bf16* o = A3X + (size_t)it * 256;
        o[lane] = (bf16)hi; o[64 + lane] = (bf16)lo; o[128 + lane] = (bf16)hi; o[192 + lane] = 0;
    }
    for (int it = gw; it < 2 * HT_ROWS; it += NGW) {
        const int j = it / HT_ROWS, col = it % HT_ROWS;
        const float w = F.inp(14)[((size_t)j * 64 + lane) * HT_ROWS + col];
        const unsigned hi = f2bf(w); const float rem = w - __builtin_bit_cast(float, hi << 16); const unsigned lo = f2bf(rem);
        bf16* o = WOX + (size_t)it * 256;
        o[lane] = (bf16)hi; o[64 + lane] = (bf16)hi; o[128 + lane] = (bf16)lo; o[192 + lane] = 0;
    }
}
struct Raw8 { v4u c; unsigned p, n; };
__device__ __forceinline__ Raw8 ld8(const unsigned* row, int q, int ngrp) {
    Raw8 r; r.c = *(const v4u*)(row + 4 * q);
    const int qm = q > 0 ? 4 * q - 1 : 0, qp = (q + 1 < ngrp) ? 4 * q + 4 : 0;
    r.p = row[qm]; r.n = row[qp]; r.p = q > 0 ? r.p : 0u; r.n = (q + 1 < ngrp) ? r.n : 0u; return r;
}
__device__ __forceinline__ void sconv8(const Raw8& r, float c0, float c1, float c2, float cb, fc::cpx (&o)[4]) {
    float u[10]; u[0] = bf_hi(r.p); u[9] = bf_lo(r.n);
#pragma unroll
    for (int e = 0; e < 4; ++e) { u[1 + 2 * e] = bf_lo(r.c[e]); u[2 + 2 * e] = bf_hi(r.c[e]); }
#pragma unroll
    for (int i = 0; i < 4; ++i) o[i] = fc::cpx{c0 * u[2 * i] + c1 * u[2 * i + 1] + c2 * u[2 * i + 2] + cb, c0 * u[2 * i + 1] + c1 * u[2 * i + 2] + c2 * u[2 * i + 3] + cb};
}
#define CONV_SYNC asm volatile("s_waitcnt lgkmcnt(0)\n\ts_barrier" ::: "memory")
#define CONV_SYNC_FULL __syncthreads()
#define RFL(x) __builtin_bit_cast(float, __builtin_amdgcn_readfirstlane(__builtin_bit_cast(int, (x))))
#define SC_LOAD(pre, col) const float pre##0 = RFL(cw[col]), pre##1 = RFL(cw[NHY + (col)]), pre##2 = RFL(cw[2 * NHY + (col)]), pre##b = RFL(cbp[col])
template <int M, int NT> __device__ __forceinline__ void conv_part(const Frame& F, int hj, int c, int nseq, int tok0, int hcol0, const unsigned short* HT, bf16* UT, bf16* ZO, fc::f4* kb) {
    constexpr int L = M, NG = (L / 8) / NT, NH = 512 / NT;
    const int hh = (NH == 2) ? (F.wave >> 2) : 0;
    int tl = F.tid & (NT - 1);
    fc::lptr lds = (fc::lptr)F.lds + hh * fc::padi(8192);
    LAS float* red = (LAS float*)(F.lds + RED_OFF);
#pragma unroll 1
    for (int oi = 0; oi < 2 / NH; ++oi) {
        const int o = (NH == 2) ? hh : oi;
        const unsigned short* hf = HT + (size_t)((o * 2 + 0) * D + c) * HT_COLS + hcol0;
        const unsigned short* hb = HT + (size_t)((o * 2 + 1) * D + c) * HT_COLS + hcol0;
        float part = 0.f;
        OPAQUE_V(tl);
        v4u raw[2 * NG]; unsigned short top[NG];
#pragma unroll
        for (int it = 0; it < 2 * NG; ++it) { const int q = tl + NT * it;
            if (it < NG) raw[it] = ((const v4u*)hf)[q];
            else { const int qp = q - L / 8; raw[it] = ((const v4u*)hb)[L / 8 - 1 - qp]; top[it - NG] = hb[qp > 0 ? L - 8 * qp : 0]; } }
#pragma unroll
        for (int it = 0; it < 2 * NG; ++it) { const int q = tl + NT * it;
            float t[8];
#pragma unroll
            for (int e = 0; e < 4; ++e) { t[2 * e] = h2f((unsigned short)(raw[it][e] & 0xffffu)); t[2 * e + 1] = h2f((unsigned short)(raw[it][e] >> 16)); }
            fc::cpx o4[4];
            if (it < NG) { o4[0] = fc::cpx{t[0], t[1]}; o4[1] = fc::cpx{t[2], t[3]}; o4[2] = fc::cpx{t[4], t[5]}; o4[3] = fc::cpx{t[6], t[7]}; }
            else { const float tp = (q - L / 8 > 0) ? h2f(top[it - NG]) : 0.f; o4[0] = fc::cpx{tp, t[7]}; o4[1] = fc::cpx{t[6], t[5]}; o4[2] = fc::cpx{t[4], t[3]}; o4[3] = fc::cpx{t[2], t[1]}; }
#pragma unroll
            for (int i = 0; i < 4; ++i) { lds[fc::padi(4 * q) + i] = o4[i]; part += fabsf(o4[i].x) + fabsf(o4[i].y); } }
        part = wave_sum(part, F.lane);
        if (F.lane == 0) red[F.wave] = part;
        CONV_SYNC;
        float S = 0.f;
#pragma unroll
        for (int w = 0; w < 8 / NH; ++w) S += red[hh * 4 + w];
        FC_FWD(M, NT, lds, tl, CONV_SYNC);
        fc::filter_pass<M, NT>(lds, tl, 1.0f / (8.0f * (float)M * S), kb + o * KB_ORDER);
        CONV_SYNC_FULL;
    }
    const float* cw = F.inp(6) + (size_t)hj * 3 * NHY; const float* cbp = F.inp(7) + (size_t)hj * NHY; const float* sk = F.inp(16) + (size_t)hj * 2 * D;
    fc::f4* z1g = kb + 2 * KB_ORDER + hh * 2048;
#pragma unroll 1
    for (int s = 0; s < nseq; s += NH) {
        const int tok = tok0 + (s + hh) * L;
        const unsigned* uv = (const unsigned*)(UT + (size_t)c * NTOK + tok);
        const unsigned* ux1 = (const unsigned*)(UT + (size_t)(D + c) * NTOK + tok);
        const unsigned* ux2 = (const unsigned*)(UT + (size_t)(2 * D + c) * NTOK + tok);
        OPAQUE_V(tl);
        { SC_LOAD(cv, c);
          Raw8 rv[NG];
#pragma unroll
          for (int j = 0; j < NG; ++j) rv[j] = ld8(uv, tl + NT * j, L / 8);
#pragma unroll
          for (int j = 0; j < NG; ++j) { const int q = tl + NT * j; fc::cpx o4[4]; sconv8(rv[j], cv0, cv1, cv2, cvb, o4);
#pragma unroll
              for (int i = 0; i < 4; ++i) { lds[fc::padi(4 * q) + i] = o4[i]; } } }
        CONV_SYNC;
        { FC_FWD12Z(M, NT, lds, tl, CONV_SYNC);
          fc::KRegs<M, NT> kr; fc::k_prefetch<M, NT>(kb, tl, kr);
          FC_FWD3(M, NT, lds, tl, CONV_SYNC);
          fc::mult_pass<M, NT>(lds, tl, kr); }
        CONV_SYNC;
        OPAQUE_V(tl);
        { Raw8 rv[NG], ra[NG];
#pragma unroll
          for (int j = 0; j < NG; ++j) { rv[j] = ld8(uv, tl + NT * j, L / 8); ra[j] = ld8(ux1, tl + NT * j, L / 8); }
          FC_INVZ(M, NT, lds, tl, CONV_SYNC);
          SC_LOAD(cv, c); SC_LOAD(ca, D + c); const float skip0 = RFL(sk[c]);
#pragma unroll
          for (int j = 0; j < NG; ++j) { const int q = tl + NT * j; fc::cpx v4[4], a4[4], z[4]; sconv8(rv[j], cv0, cv1, cv2, cvb, v4); sconv8(ra[j], ca0, ca1, ca2, cab, a4);
#pragma unroll
              for (int i = 0; i < 4; ++i) { const fc::cpx y = lds[fc::padi(4 * q) + i]; z[i] = a4[i] * (y + skip0 * v4[i]); lds[fc::padi(4 * q) + i] = z[i]; }
              z1g[(j * NT + tl) * 2] = fc::f4{z[0].x, z[0].y, z[1].x, z[1].y}; z1g[(j * NT + tl) * 2 + 1] = fc::f4{z[2].x, z[2].y, z[3].x, z[3].y}; } }
        CONV_SYNC;
        { FC_FWD12Z(M, NT, lds, tl, CONV_SYNC);
          fc::KRegs<M, NT> kr; fc::k_prefetch<M, NT>(kb + KB_ORDER, tl, kr);
          FC_FWD3(M, NT, lds, tl, CONV_SYNC);
          fc::mult_pass<M, NT>(lds, tl, kr); }
        CONV_SYNC;
        OPAQUE_V(tl);
        { Raw8 rx[NG]; fc::f4 zp[NG][2];
#pragma unroll
          for (int j = 0; j < NG; ++j) { rx[j] = ld8(ux2, tl + NT * j, L / 8); zp[j][0] = z1g[(j * NT + tl) * 2]; zp[j][1] = z1g[(j * NT + tl) * 2 + 1]; }
          FC_INVZ(M, NT, lds, tl, CONV_SYNC);
          SC_LOAD(cx, 2 * D + c); const float skip1 = RFL(sk[D + c]);
          v4u* zo = (v4u*)(ZO + (size_t)c * NTOK + tok);
#pragma unroll
          for (int j = 0; j < NG; ++j) { const int q = tl + NT * j; fc::cpx x4[4]; sconv8(rx[j], cx0, cx1, cx2, cxb, x4);
              unsigned w[4];
#pragma unroll
              for (int i = 0; i < 4; ++i) { const fc::cpx y = lds[fc::padi(4 * q) + i]; const fc::cpx z1 = fc::cpx{zp[j][i >> 1][2 * (i & 1)], zp[j][i >> 1][2 * (i & 1) + 1]}; const fc::cpx z2 = x4[i] * (y + skip1 * z1); w[i] = pk2(z2.x, z2.y); }
              zo[q] = v4u{w[0], w[1], w[2], w[3]}; } }
        CONV_SYNC;
    }
}
__device__ __forceinline__ void conv_phase(const Frame& F, int hj, const unsigned short* HT, bf16* UT, bf16* ZO, fc::f4* KB) {
    fc::f4* kb = KB + (size_t)F.bx * KB_BLOCK;
    for (int c = F.bx; c < D; c += F.G) {
        conv_part<LP, 256>(F, hj, c, NBP, 0, 0, HT, UT, ZO, kb);
        conv_part<LS, 512>(F, hj, c, 1, NTOKP, LP, HT, UT, ZO, kb);
    }
}
__device__ __forceinline__ void transpose_phase(const Frame& F, const bf16* ZT, bf16* Z) {
    constexpr int PIT = 68;
    LAS bf16* t = (LAS bf16*)(F.lds + F.wave * (64 * PIT * 2));
    const int gw = F.vcu * NWAVES + F.wave, NGW = F.G * NWAVES, lane = F.lane;
    constexpr int TN = NTOK / 64, NTILE = (D / 64) * TN;
    v4u w[8];
    if (gw < NTILE) { const int cb = gw / TN, tb = gw % TN;
#pragma unroll
        for (int i = 0; i < 8; ++i) w[i] = *(const GAS v4u*)(ZT + (size_t)(64 * cb + 8 * i + (lane >> 3)) * NTOK + 64 * tb + 8 * (lane & 7)); }
    for (int it = gw; it < NTILE; it += NGW) {
        const int cb = it / TN, tb = it % TN, c0 = 64 * cb, t0 = 64 * tb;
#pragma unroll
        for (int i = 0; i < 8; ++i) { const int ch = 8 * i + (lane >> 3), t8 = lane & 7;
            LAS v2u* p = (LAS v2u*)(t + ch * PIT + 8 * t8); p[0] = v2u{w[i].x, w[i].y}; p[1] = v2u{w[i].z, w[i].w}; }
        { const int in = (it + NGW < NTILE) ? it + NGW : it, cbn = in / TN, tbn = in % TN;
#pragma unroll
          for (int i = 0; i < 8; ++i) w[i] = *(const GAS v4u*)(ZT + (size_t)(64 * cbn + 8 * i + (lane >> 3)) * NTOK + 64 * tbn + 8 * (lane & 7)); }
        LDS_WAIT(); asm volatile("" ::: "memory");
#pragma unroll
        for (int i = 0; i < 8; ++i) { const int tk = 8 * i + (lane >> 3), c8 = lane & 7;
            const LAS bf16* s = t + (8 * c8) * PIT + tk;
            v4u o; o.x = (unsigned)s[0] | ((unsigned)s[PIT] << 16); o.y = (unsigned)s[2 * PIT] | ((unsigned)s[3 * PIT] << 16);
            o.z = (unsigned)s[4 * PIT] | ((unsigned)s[5 * PIT] << 16); o.w = (unsigned)s[6 * PIT] | ((unsigned)s[7 * PIT] << 16);
            *(GAS v4u*)(Z + (size_t)(t0 + tk) * D + c0 + 8 * c8) = o; }
        LDS_WAIT(); asm volatile("" ::: "memory");
    }
}
constexpr int ATT_BW = 321;
constexpr int ATT_KPITCH = 272, ATT_VPITCH = 320, ATT_K_OFF = 0, ATT_V_OFF = 128 * ATT_KPITCH, ATT_B_OFF = ATT_V_OFF + 128 * ATT_VPITCH, ATT_QPITCH = 272, ATT_STAGE = 32 * ATT_QPITCH, ATT_UNITS = (NTOK / 128) * NKV * 2;
__device__ __forceinline__ int t5_bucket(int rel) {
    const int n = rel < 0 ? -rel : rel; int b;
    if (n < 8) b = n; else if (n < 12) b = 8; else if (n < 16) b = 9; else if (n < 23) b = 10; else if (n < 32) b = 11; else if (n < 46) b = 12; else if (n < 64) b = 13; else if (n < 91) b = 14; else b = 15;
    return b + (rel > 0 ? 16 : 0);
}
typedef short v4i16_t __attribute__((ext_vector_type(4)));
__device__ __forceinline__ void attn_phase(const Frame& F, int aj, const bf16* QKV, bf16* O, const int dry = 0) {
    const int tid = F.tid, lane = F.lane, wave = F.wave, r32 = lane & 31, hi = lane >> 5;
    LAS unsigned char* lds = F.lds;
    LAS float* btab = (LAS float*)(lds + ATT_B_OFF);
    const float* qg = F.inp(20) + aj * HD; const float* kg = F.inp(21) + aj * HD; const float* sink = F.inp(22) + aj * NHEAD; const float* relb = F.inp(24);
    constexpr float LOG2E = 1.4426950408889634f;
    const int per = (ATT_UNITS + F.G - 1) / F.G;
    const int c16 = tid & 15, srow = tid >> 4;
    LAS float* qkt = (LAS float*)(lds + ATT_B_OFF + NHEAD * ATT_BW * 4);
    if (tid < HD) qkt[tid] = qg[tid] * kg[tid] * (0.08838834764831845f * 1.4426950408889634f);
    const int vtr = (4 * hi + ((lane >> 2) & 3)) * ATT_VPITCH + (16 * ((lane >> 4) & 1) + 4 * (lane & 3)) * 2;
    for (int idx = tid; idx < NHEAD * ATT_BW; idx += 512) { const int hh = idx / ATT_BW, rel = idx % ATT_BW - 160; btab[idx] = (rel >= -128 && rel <= 128) ? relb[t5_bucket(rel) * NHEAD + hh] * LOG2E : -1e30f; }
    __syncthreads();
    if (wave >= 4) __builtin_amdgcn_s_setprio(1);
    LAS unsigned char* stg = lds + wave * ATT_STAGE;
    const int st_row = lane >> 4, st_c16 = lane & 15;
    auto first_src = [&](int uu) -> const bf16* {
        const int g_ = (uu >> 1) & 3, blk_ = uu >> 3; int tokS_, n_;
        if (blk_ < 256) { tokS_ = (blk_ >> 6) * LP; n_ = blk_ & 63; } else { tokS_ = NTOKP; n_ = blk_ - 256; }
        return QKV + (size_t)(tokS_ + (n_ + ((n_ == 0) ? 1 : 0) - 1) * 128 + srow) * NQKV + 2048 + g_ * HD + 8 * c16;
    };
    const int qo = 32 * ((0x12032130u >> (4 * wave)) & 3);
    auto q_src = [&](int uu) -> const bf16* {
        const int hp_ = uu & 1, g_ = (uu >> 1) & 3, blk_ = uu >> 3; int tokS_, n_;
        if (blk_ < 256) { tokS_ = (blk_ >> 6) * LP; n_ = blk_ & 63; } else { tokS_ = NTOKP; n_ = blk_ - 256; }
        return QKV + (size_t)(tokS_ + n_ * 128 + qo + st_row) * NQKV + (4 * g_ + 2 * hp_ + (wave >> 2)) * HD + 8 * st_c16;
    };
    v4u qv[8];
    if (F.vcu * per < ATT_UNITS) { const bf16* qsrc = q_src(F.vcu * per);
#pragma unroll
        for (int i = 0; i < 8; ++i) qv[i] = *(const GAS v4u*)(qsrc + (size_t)(4 * i) * NQKV); }
    v4u kr[4], vr[4];
    if (F.vcu * per < ATT_UNITS) { const bf16* src = first_src(F.vcu * per);
#pragma unroll
        for (int p = 0; p < 4; ++p) { kr[p] = *(const GAS v4u*)(src + (size_t)(32 * p) * NQKV); vr[p] = *(const GAS v4u*)(src + (size_t)(32 * p) * NQKV + 512); } }
#pragma unroll 1
    for (int ui = 0; ui < per; ++ui) {
        const int u = F.vcu * per + ui;
        if (u >= ATT_UNITS) break;
        const int hp = u & 1, g = (u >> 1) & 3, blk = u >> 3;
        int tokS, L, n;
        if (blk < 256) { tokS = (blk >> 6) * LP; L = LP; n = blk & 63; } else { tokS = NTOKP; L = LS; n = blk - 256; }
        const int head = 4 * g + 2 * hp + (wave >> 2);
        const int ck0 = (n == 0) ? 1 : 0, ck1 = (n == L / 128 - 1) ? 1 : 2;
        bf16x8 qf[8];
        {
#pragma unroll
            for (int i = 0; i < 8; ++i) *(LAS v4u*)(stg + (st_row + 4 * i) * ATT_QPITCH + 16 * st_c16) = qv[i];
            LDS_WAIT(); asm volatile("" ::: "memory");
            v4u raw[8]; float ss = 0.f;
#pragma unroll
            for (int d0 = 0; d0 < 8; ++d0) { raw[d0] = *(const LAS v4u*)(stg + r32 * ATT_QPITCH + 32 * d0 + 16 * hi);
#pragma unroll
                for (int e = 0; e < 4; ++e) { const float a = bf_lo(raw[d0][e]), b = bf_hi(raw[d0][e]); ss += a * a + b * b; } }
            ss = sum_halves(ss);
            const float sc = __builtin_amdgcn_rsqf(ss * (1.0f / HD) + EPS);
            int hq = hi; OPAQUE_V(hq);
#pragma unroll
            for (int d0 = 0; d0 < 8; ++d0) { const f32x4 g0 = *(const LAS f32x4*)(qkt + 16 * d0 + 8 * hq), g1 = *(const LAS f32x4*)(qkt + 16 * d0 + 8 * hq + 4);
                v4u w;
                w.x = pk2(bf_lo(raw[d0].x) * sc * g0.x, bf_hi(raw[d0].x) * sc * g0.y); w.y = pk2(bf_lo(raw[d0].y) * sc * g0.z, bf_hi(raw[d0].y) * sc * g0.w);
                w.z = pk2(bf_lo(raw[d0].z) * sc * g1.x, bf_hi(raw[d0].z) * sc * g1.y); w.w = pk2(bf_lo(raw[d0].w) * sc * g1.z, bf_hi(raw[d0].w) * sc * g1.w);
                qf[d0] = __builtin_bit_cast(bf16x8, w); }
        }
        float mrun = sink[head] * LOG2E, lrun = (hi == 0) ? 1.0f : 0.0f;
        f32x16 negm;
#pragma unroll
        for (int e = 0; e < 16; ++e) negm[e] = -mrun;
        f32x16 oacc[4];
#pragma unroll
        for (int dt = 0; dt < 4; ++dt)
#pragma unroll
            for (int e = 0; e < 16; ++e) oacc[dt][e] = 0.f;
#pragma unroll 1
        for (int ck = ck0; ck <= (dry >= 3 ? ck0 - 1 : ck1); ++ck) {
            __syncthreads();
#pragma unroll
            for (int p = 0; p < 4; ++p) { const int row = srow + 32 * p;
                float ss = 0.f;
#pragma unroll
                for (int e = 0; e < 4; ++e) { const float a = bf_lo(kr[p][e]), b = bf_hi(kr[p][e]); ss += a * a + b * b; }
                ss = sum16(ss);
                const float rs = __builtin_amdgcn_rsqf(ss * (1.0f / HD) + EPS);
                v4u w;
                w.x = pk2(bf_lo(kr[p].x) * rs, bf_hi(kr[p].x) * rs); w.y = pk2(bf_lo(kr[p].y) * rs, bf_hi(kr[p].y) * rs);
                w.z = pk2(bf_lo(kr[p].z) * rs, bf_hi(kr[p].z) * rs); w.w = pk2(bf_lo(kr[p].w) * rs, bf_hi(kr[p].w) * rs);
                *(LAS v4u*)(lds + ATT_K_OFF + row * ATT_KPITCH + 16 * c16) = w;
                *(LAS v4u*)(lds + ATT_V_OFF + row * ATT_VPITCH + 16 * c16) = vr[p]; }
            __syncthreads();
            if (ck < ck1 || (ui + 1 < per && u + 1 < ATT_UNITS)) {
                const bf16* src = (ck < ck1) ? QKV + (size_t)(tokS + (n + ck) * 128 + srow) * NQKV + 2048 + g * HD + 8 * c16 : first_src(u + 1);
#pragma unroll
                for (int p = 0; p < 4; ++p) { kr[p] = *(const GAS v4u*)(src + (size_t)(32 * p) * NQKV); vr[p] = *(const GAS v4u*)(src + (size_t)(32 * p) * NQKV + 512); } }
#pragma unroll 1
            for (int kt = 0; kt < (dry >= 2 ? 0 : 4); ++kt) {
                const int T = 4 * ck + kt;
                if (T < (qo >> 5) || T > (qo >> 5) + 8) continue;
                const int relb0 = 32 * T + 4 * hi - 128 - (qo + r32);
                const LAS float* bt = btab + head * ATT_BW + 160;
                f32x16 sacc, sacc2;
                { unsigned bpa = (unsigned)(unsigned long long)(bt + relb0); OPAQUE_V(bpa); const LAS float* bp = (const LAS float*)(unsigned long long)bpa;
#pragma unroll
                  for (int e = 0; e < 16; ++e) sacc[e] = bp[(e & 3) + 8 * (e >> 2)]; }
                const LAS unsigned char* kp = lds + ATT_K_OFF + (32 * kt + r32) * ATT_KPITCH + 16 * hi;
                bf16x8 kfr[8];
                asm volatile("ds_read_b128 %0, %8\n\tds_read_b128 %1, %8 offset:32\n\tds_read_b128 %2, %8 offset:64\n\tds_read_b128 %3, %8 offset:96\n\t"
                             "ds_read_b128 %4, %8 offset:128\n\tds_read_b128 %5, %8 offset:160\n\tds_read_b128 %6, %8 offset:192\n\tds_read_b128 %7, %8 offset:224"
                             : "=&v"(kfr[0]), "=&v"(kfr[1]), "=&v"(kfr[2]), "=&v"(kfr[3]), "=&v"(kfr[4]), "=&v"(kfr[5]), "=&v"(kfr[6]), "=&v"(kfr[7]) : "v"(kp) : "memory");
                asm volatile("s_waitcnt lgkmcnt(0)" : "+v"(kfr[0]), "+v"(kfr[1]), "+v"(kfr[2]), "+v"(kfr[3]), "+v"(kfr[4]), "+v"(kfr[5]), "+v"(kfr[6]), "+v"(kfr[7]));
#pragma unroll
                for (int d0 = 0; d0 < 8; d0 += 2) { sacc2 = __builtin_amdgcn_mfma_f32_32x32x16_bf16(kfr[d0 + 1], qf[d0 + 1], d0 == 0 ? negm : sacc2, 0, 0, 0); sacc = __builtin_amdgcn_mfma_f32_32x32x16_bf16(kfr[d0], qf[d0], sacc, 0, 0, 0); }
#pragma unroll
                for (int e = 0; e < 16; ++e) sacc[e] += sacc2[e];
                float mx = -1e30f;
#pragma unroll
                for (int e = 0; e < 16; ++e) mx = fmaxf(mx, sacc[e]);
                mx = max_halves(mx);
                if (__builtin_amdgcn_ballot_w64(mx > 8.0f) != 0ull) {
                    const float dm = fmaxf(mx, 0.f), alpha = __builtin_amdgcn_exp2f(-dm);
                    mrun += dm; lrun *= alpha;
#pragma unroll
                    for (int e = 0; e < 16; ++e) { sacc[e] -= dm; negm[e] = -mrun; }
#pragma unroll
                    for (int dt = 0; dt < 4; ++dt)
#pragma unroll
                        for (int e = 0; e < 16; ++e) oacc[dt][e] *= alpha; }
                float ps = 0.f;
#pragma unroll
                for (int e = 0; e < 16; ++e) { const float p = __builtin_amdgcn_exp2f(sacc[e]); sacc[e] = p; ps += p; }
                lrun += ps;
                bf16x8 pf[2];
#pragma unroll
                for (int s = 0; s < 2; ++s) { v4u w; w.x = pk2(sacc[8 * s + 0], sacc[8 * s + 1]); w.y = pk2(sacc[8 * s + 2], sacc[8 * s + 3]); w.z = pk2(sacc[8 * s + 4], sacc[8 * s + 5]); w.w = pk2(sacc[8 * s + 6], sacc[8 * s + 7]);
                    pf[s] = __builtin_bit_cast(bf16x8, w); }
#pragma unroll
                for (int s = 0; s < 2; ++s)
                { v4i16_t a0[4], a1[4];
#pragma unroll
                    for (int dt = 0; dt < 4; ++dt) { const LAS unsigned char* vp = lds + ATT_V_OFF + (32 * kt) * ATT_VPITCH + 64 * dt + vtr;
                        a0[dt] = __builtin_amdgcn_ds_read_tr16_b64_v4i16((LAS v4i16_t*)(vp + (16 * s) * ATT_VPITCH));
                        a1[dt] = __builtin_amdgcn_ds_read_tr16_b64_v4i16((LAS v4i16_t*)(vp + (16 * s + 8) * ATT_VPITCH)); }
#pragma unroll
                    for (int dt = 0; dt < 4; ++dt) { const bf16x8 af = (bf16x8){a0[dt][0], a0[dt][1], a0[dt][2], a0[dt][3], a1[dt][0], a1[dt][1], a1[dt][2], a1[dt][3]};
                        oacc[dt] = __builtin_amdgcn_mfma_f32_32x32x16_bf16(af, pf[s], oacc[dt], 0, 0, 0); } }
            }
        }
        const float ltot = sum_halves(lrun), inv = __builtin_amdgcn_rcpf(ltot);
        { const bf16* qsrc = q_src((ui + 1 < per && u + 1 < ATT_UNITS) ? u + 1 : u);
#pragma unroll
            for (int i = 0; i < 8; ++i) qv[i] = *(const GAS v4u*)(qsrc + (size_t)(4 * i) * NQKV); }
        __syncthreads();
#pragma unroll
        for (int dt = 0; dt < 4; ++dt)
#pragma unroll
            for (int q4 = 0; q4 < 4; ++q4) { v2u w; w.x = pk2(oacc[dt][4 * q4] * inv, oacc[dt][4 * q4 + 1] * inv); w.y = pk2(oacc[dt][4 * q4 + 2] * inv, oacc[dt][4 * q4 + 3] * inv);
                *(LAS v2u*)(stg + r32 * ATT_QPITCH + (32 * dt + 8 * q4 + 4 * hi) * 2) = w; }
        LDS_WAIT(); asm volatile("" ::: "memory");
        { bf16* odst = O + (size_t)(tokS + n * 128 + qo + st_row) * D + head * HD + 8 * st_c16;
#pragma unroll
          for (int i = 0; i < 8; ++i) { const v4u w = *(const LAS v4u*)(stg + (st_row + 4 * i) * ATT_QPITCH + 16 * st_c16); *(GAS v4u*)(odst + (size_t)(4 * i) * D) = w; } }
    }
    __builtin_amdgcn_s_setprio(0);
}

__global__ void __launch_bounds__(NWAVES * 64, 2) trunk_fwd(Args args) {
    extern __shared__ __attribute__((aligned(16))) unsigned char lds_raw[];
    Frame F;
    F.lds = (LAS unsigned char*)lds_raw;
    F.tid = threadIdx.x; F.lane = F.tid & 63; F.wave = __builtin_amdgcn_readfirstlane(F.tid >> 6);
    F.G = gridDim.x; F.bx = blockIdx.x; { const int bx = blockIdx.x; F.vcu = (F.G % 8 == 0) ? (bx % 8) * (F.G / 8) + bx / 8 : bx; }
    volatile LAS unsigned* MISC = (volatile LAS unsigned*)(F.lds + MISC_OFF);
    if (F.tid < 64) MISC[F.tid] = 0u;
    __syncthreads();
    if (F.tid < 27) { const unsigned long long v = (unsigned long long)args.in[F.tid]; MISC[64 + 2 * F.tid] = (unsigned)v; MISC[65 + 2 * F.tid] = (unsigned)(v >> 32); }
    if (F.tid == 27) { const unsigned long long v = (unsigned long long)args.out; MISC[64 + 54] = (unsigned)v; MISC[64 + 55] = (unsigned)(v >> 32); }
    if (F.tid == 28) { const unsigned long long v = (unsigned long long)args.ws; MISC[64 + 56] = (unsigned)v; MISC[64 + 57] = (unsigned)(v >> 32); }
    __syncthreads();
    XcdBarrier bar; bar.bar = (unsigned*)(args.ws + WS_CTL) + CW_BAR; bar.x = 0; bar.st = nullptr;
    if (!MK_PER_PHASE) bar = xcd_barrier_post((unsigned*)(args.ws + WS_CTL) + CW_BAR, MISC + 8);
    const int lo = args.ph_lo, hi = args.ph_hi;
#if defined(PROBE_REP) || defined(PROBE_ATT) || defined(PROBE_UB)
    const int dry = args.dry;
#else
    constexpr int dry = 0;
#endif
#define IN(k) (lo <= (k) && (k) < hi)
#define SEAM(k) do { if (IN(k) && IN((k) + 1)) xcd_barrier(bar); } while (0)
#define WSB(off) ((bf16*)(Fp.wsp() + (off)))

#define RSS(n) ((float*)(Fp.wsp() + WS_RSS) + (size_t)((n) & 1) * NTOK * 8)
#define EPART ((pg8_las_f*)(Fp.lds + 131072))
#define ETAB ((pg8_las_f*)(Fp.lds + 131072 + 4096))
#define ERAW ((pg8_las_f*)(Fp.lds + 131072 + 5120))
#ifdef PROBE_UB
    if (IN(0) && dry >= 2) { PH_FRAME(Fp);
        typedef float f2 __attribute__((ext_vector_type(2)));
        f2 acc[16]; float s = (float)Fp.tid * 1e-9f;
#pragma unroll
        for (int i = 0; i < 16; ++i) acc[i] = (f2){s + i, s - i};
        const f2 m = (f2){0.999f, 0.998f}, ad = (f2){1e-3f, 2e-3f};
#pragma unroll 1
        for (int it = 0; it < 16384; ++it) {
#pragma unroll
            for (int i = 0; i < 16; ++i) {
                if (dry == 2) asm volatile("v_pk_fma_f32 %0, %0, %1, %2" : "+v"(acc[i]) : "v"(m), "v"(ad));
                else if (dry == 3) asm volatile("v_fma_f32 %0, %0, %1, %2" : "+v"(acc[i].x) : "v"(m.x), "v"(ad.x));
                else asm volatile("v_pk_add_f32 %0, %0, %1" : "+v"(acc[i]) : "v"(ad));
            }
        }
        float t = 0.f;
#pragma unroll
        for (int i = 0; i < 16; ++i) t += acc[i].x + acc[i].y;
        if (t != t) ((float*)WSB(WS_KB))[Fp.tid] = t;
    } else
#endif
    if (IN(0)) { PH_FRAME(Fp);
        filter_mlp(Fp, WSB(WS_A3X), WSB(WS_WOX));
        cvt_weight<0>(Fp, Fp.inp(4), Fp.inp(2), D, NHY, WSB(WS_WMA));
        cvt_weight<0>(Fp, Fp.inp(17), nullptr, D, D, WSB(WS_WMB));
        prep_rows(Fp, Fp.inp(0), Fp.inp(1), WSB(WS_XN), RSS(0));
    }
    SEAM(0);
#pragma unroll 1
    for (int p = 0; p < 2; ++p) {
        const int base = 1 + 11 * p;
        {
            const int layer = 2 * p;
            if (IN(base + 0)) { PH_FRAME(Fp);
                { pg8::Gemm g{WSB(WS_WMA), WSB(WS_XN), NHY, NTOK, D}; pg8::StaticOrder S; S.init(NHY, NTOK, Fp.G, Fp.bx);
                  pg8::EpiBf16 E{WSB(WS_BIG), NTOK, Fp.inp(5) + (size_t)p * NHY, nullptr, RSS(2 * layer), ETAB, ERAW};
                  pg8::gemm_phase<pg8::EpiBf16, pg8::StaticOrder, true, true>(Fp.lds, g, S, E, Fp.wave); }
                { int kt = 256; OPAQUE_S(kt);
                  pg8::Gemm g{WSB(WS_WOX) + (size_t)p * HT_ROWS * 256, WSB(WS_A3X) + (size_t)p * HT_COLS * 256, HT_ROWS, HT_COLS, kt}; pg8::StaticOrder S; S.init(HT_ROWS, HT_COLS, Fp.G, Fp.bx);
                  pg8::EpiTaps E{(unsigned short*)WSB(WS_HT), HT_COLS};
                  pg8::gemm_phase<pg8::EpiTaps, pg8::StaticOrder, true, true>(Fp.lds, g, S, E, Fp.wave); }
            }
            SEAM(base + 0);
            if (IN(base + 1)) { PH_FRAME(Fp);
                cvt_weight<1>(Fp, Fp.inp(25) + (size_t)layer * D * NGU, Fp.inp(3) + layer * D, D, NGU, WSB(WS_WGU));
                cvt_weight<0>(Fp, Fp.inp(26) + (size_t)layer * DFF * D, nullptr, DFF, D, WSB(WS_WDN));
                __syncthreads();
                conv_phase(Fp, p, (unsigned short*)WSB(WS_HT), WSB(WS_BIG), dry ? WSB(WS_XN) : WSB(WS_BIG), (fc::f4*)WSB(WS_KB));
            }
            SEAM(base + 1);
            if (IN(base + 2)) { PH_FRAME(Fp); transpose_phase(Fp, WSB(WS_BIG), WSB(WS_HT)); }
            SEAM(base + 2);
            if (IN(base + 3)) { PH_FRAME(Fp);
                pg8::Gemm g{WSB(WS_HT), WSB(WS_WMB), NTOK, D, D}; pg8::StaticOrder S; S.init(NTOK, D, Fp.G, Fp.bx);
                pg8::EpiRes16 E{WSB(WS_XN), D, Fp.inp(18) + (size_t)p * D, nullptr, RSS(2 * layer + 1), EPART};
                pg8::gemm_phase<pg8::EpiRes16, pg8::StaticOrder, true, true>(Fp.lds, g, S, E, Fp.wave);
            }
            SEAM(base + 3);
            if (IN(base + 4)) { PH_FRAME(Fp);
                cvt_weight<0>(Fp, Fp.inp(19) + (size_t)p * D * NQKV, Fp.inp(2) + (layer + 1) * D, D, NQKV, WSB(WS_WMA));
                cvt_weight<0>(Fp, Fp.inp(23) + (size_t)p * D * D, nullptr, D, D, WSB(WS_WMB));
                __syncthreads();
                pg8::Gemm g{WSB(WS_XN), WSB(WS_WGU), NTOK, NGU, D}; pg8::StaticOrder S; S.init(NTOK, NGU, Fp.G, Fp.bx);
                pg8::EpiSwiGLU E{WSB(WS_BIG), DFF, RSS(2 * layer + 1), ETAB, ERAW};
                pg8::gemm_phase<pg8::EpiSwiGLU, pg8::StaticOrder, true, true>(Fp.lds, g, S, E, Fp.wave);
            }
            SEAM(base + 4);
            if (IN(base + 5)) { PH_FRAME(Fp);
                pg8::Gemm g{WSB(WS_BIG), WSB(WS_WDN), NTOK, D, DFF}; pg8::StaticOrder S; S.init(NTOK, D, Fp.G, Fp.bx);
                pg8::EpiRes16 E{WSB(WS_XN), D, nullptr, nullptr, RSS(2 * layer + 2), EPART};
                pg8::gemm_phase<pg8::EpiRes16, pg8::StaticOrder, true, true>(Fp.lds, g, S, E, Fp.wave);
            }
            SEAM(base + 5);
        }
        {
            const int layer = 2 * p + 1;
            if (IN(base + 6)) { PH_FRAME(Fp);
                pg8::Gemm g{WSB(WS_XN), WSB(WS_WMA), NTOK, NQKV, D}; pg8::StaticOrder S; S.init(NTOK, NQKV, Fp.G, Fp.bx);
                pg8::EpiBf16 E{WSB(WS_BIG), NQKV, nullptr, RSS(2 * layer), nullptr, ETAB, ERAW};
                pg8::gemm_phase<pg8::EpiBf16, pg8::StaticOrder, true, true>(Fp.lds, g, S, E, Fp.wave);
            }
            SEAM(base + 6);
            if (IN(base + 7)) { PH_FRAME(Fp);
                cvt_weight<1>(Fp, Fp.inp(25) + (size_t)layer * D * NGU, Fp.inp(3) + layer * D, D, NGU, WSB(WS_WGU));
                cvt_weight<0>(Fp, Fp.inp(26) + (size_t)layer * DFF * D, nullptr, DFF, D, WSB(WS_WDN));
                __syncthreads();
                attn_phase(Fp, p, WSB(WS_BIG), WSB(WS_HT), dry);
            }
            SEAM(base + 7);
            if (IN(base + 8)) { PH_FRAME(Fp);
                pg8::Gemm g{WSB(WS_HT), WSB(WS_WMB), NTOK, D, D}; pg8::StaticOrder S; S.init(NTOK, D, Fp.G, Fp.bx);
                pg8::EpiRes16 E{WSB(WS_XN), D, nullptr, nullptr, RSS(2 * layer + 1), EPART};
                pg8::gemm_phase<pg8::EpiRes16, pg8::StaticOrder, true, true>(Fp.lds, g, S, E, Fp.wave);
            }
            SEAM(base + 8);
            if (IN(base + 9)) { PH_FRAME(Fp);
                if (p == 0) { cvt_weight<0>(Fp, Fp.inp(4) + (size_t)D * NHY, Fp.inp(2) + (layer + 1) * D, D, NHY, WSB(WS_WMA));
                              cvt_weight<0>(Fp, Fp.inp(17) + (size_t)D * D, nullptr, D, D, WSB(WS_WMB)); }
                __syncthreads();
                pg8::Gemm g{WSB(WS_XN), WSB(WS_WGU), NTOK, NGU, D}; pg8::StaticOrder S; S.init(NTOK, NGU, Fp.G, Fp.bx);
                pg8::EpiSwiGLU E{WSB(WS_BIG), DFF, RSS(2 * layer + 1), ETAB, ERAW};
                pg8::gemm_phase<pg8::EpiSwiGLU, pg8::StaticOrder, true, true>(Fp.lds, g, S, E, Fp.wave);
            }
            SEAM(base + 9);
            if (IN(base + 10)) { PH_FRAME(Fp);
                pg8::Gemm g{WSB(WS_BIG), WSB(WS_WDN), NTOK, D, DFF}; pg8::StaticOrder S; S.init(NTOK, D, Fp.G, Fp.bx);
                pg8::EpiRes16 E{WSB(WS_XN), D, nullptr, p == 0 ? (float*)nullptr : Fp.outp(), p == 0 ? RSS(2 * layer + 2) : (float*)nullptr, EPART};
                pg8::gemm_phase<pg8::EpiRes16, pg8::StaticOrder, true, true>(Fp.lds, g, S, E, Fp.wave);
            }
            SEAM(base + 10);
        }
    }
#undef RSS
#undef EPART
#undef ETAB
#undef ERAW
#undef IN
#undef SEAM
#undef WSB
}

extern "C" void kernel_launch(void* const* d_in, const int* in_sizes, int n_in, void* d_out, int out_size, void* d_ws, size_t ws_size, hipStream_t stream) {
    static int grid = 0;
    if (grid == 0) {
        if (n_in != 27 || out_size != NTOK * D || ws_size < WS_END) { fprintf(stderr, "kernel_launch: unexpected shapes: n_in %d out %d ws %zu (need %zu)\n", n_in, out_size, ws_size, (size_t)WS_END); grid = -1; return; }
        int dev = 0, cus = 0, per_cu = 0;
        if (hipGetDevice(&dev) != hipSuccess || hipDeviceGetAttribute(&cus, hipDeviceAttributeMultiprocessorCount, dev) != hipSuccess) { grid = -1; return; }
        if (hipFuncSetAttribute((const void*)trunk_fwd, hipFuncAttributeMaxDynamicSharedMemorySize, LDS_BYTES) != hipSuccess) { fprintf(stderr, "kernel_launch: hipFuncSetAttribute failed\n"); grid = -1; return; }
        if (hipOccupancyMaxActiveBlocksPerMultiprocessor(&per_cu, (const void*)trunk_fwd, NWAVES * 64, LDS_BYTES) != hipSuccess || per_cu < 1) fprintf(stderr, "kernel_launch: occupancy query reports %d\n", per_cu);
        (void)hipGetLastError();
        grid = cus;
        if (grid != 256) fprintf(stderr, "kernel_launch: %d CUs (built for 256)\n", grid);
    }
    if (grid < 0) return;
    if (hipMemsetAsync((char*)d_ws + WS_CTL, 0, CTL_ZERO_BYTES, stream) != hipSuccess) return;
    Args a{};
    for (int i = 0; i < 27; ++i) a.in[i] = (const float*)d_in[i];
    a.out = (float*)d_out; a.ws = (unsigned char*)d_ws;
#if MK_PER_PHASE
    for (int ph = 0; ph < NPHASE; ++ph) {
        a.ph_lo = ph; a.ph_hi = ph + 1;
#ifdef PROBE_REP
        { const int kk = ph == 0 ? -1 : (ph - 1) % 11;
          const int cls = (ph == 0 || kk == 2) ? 64 : (kk == 0 || kk == 6) ? 1 : (kk == 1) ? 2 : (kk == 7) ? 4 : (kk == 4 || kk == 9) ? 8 : (kk == 3 || kk == 8) ? 16 : 32;
#ifdef PROBE_ATT
          if (kk == 7) { a.dry = PROBE_ATT; hipLaunchKernelGGL(trunk_fwd, dim3(grid), dim3(NWAVES * 64), LDS_BYTES, stream, a); a.dry = 0; }
#endif
#ifdef PROBE_UB
          if (ph == 0) { a.dry = PROBE_UB; hipLaunchKernelGGL(trunk_fwd, dim3(grid), dim3(NWAVES * 64), LDS_BYTES, stream, a); a.dry = 0; }
#endif
          if (PROBE_REP & cls) { a.dry = 1; hipLaunchKernelGGL(trunk_fwd, dim3(grid), dim3(NWAVES * 64), LDS_BYTES, stream, a); a.dry = 0; } }
#endif
        hipLaunchKernelGGL(trunk_fwd, dim3(grid), dim3(NWAVES * 64), LDS_BYTES, stream, a);
    }
#else
    a.ph_lo = 0; a.ph_hi = NPHASE;
    hipLaunchKernelGGL(trunk_fwd, dim3(grid), dim3(NWAVES * 64), LDS_BYTES, stream, a);
#endif
    const hipError_t le = hipPeekAtLastError();
    if (le != hipSuccess) fprintf(stderr, "kernel_launch: launch failed: %s\n", hipGetErrorName(le));
}
```
